# Optimizing an MI355X kernel written in HIP

```python
import jax, jax.numpy as jnp
from jax import lax
import numpy as np

D_MODEL = 1024
BATCH = 2
SEQ = 16384
DEPTH = 4

N_MIXERS = 2
N_HEADS = 16
HEAD_DIM = D_MODEL // N_HEADS
Q_BLOCK = 128
CONV_WIDTH = 3
D_FF = 4 * D_MODEL
PLE_DIM = 256
N_ATTN = (DEPTH + 1) // 2
N_CONV = DEPTH // 2
RMS_EPS = 1e-6
NEG_INF = -1e30

kernel_name = "fox_shortconv_hybrid_trunk"


def rmsnorm(x, g):
    xf = x.astype(jnp.float32)
    y = xf * lax.rsqrt(jnp.mean(xf * xf, axis=-1, keepdims=True) + RMS_EPS)
    return (y * g.astype(jnp.float32)).astype(x.dtype)


def fox_attention(h, w_in, b_f, w_out):
    B, S, D = h.shape
    proj = h @ w_in
    q = proj[..., :D].reshape(B, S, N_HEADS, HEAD_DIM).transpose(0, 2, 1, 3)
    k = proj[..., D:2 * D].reshape(B, S, N_HEADS, HEAD_DIM).transpose(0, 2, 1, 3)
    v = proj[..., 2 * D:3 * D].reshape(B, S, N_HEADS, HEAD_DIM).transpose(0, 2, 1, 3)
    q = q * jnp.asarray(HEAD_DIM ** -0.5, q.dtype)
    f_logit = (proj[..., 3 * D:] + b_f).astype(jnp.float32)
    log_f = jax.nn.log_sigmoid(f_logit)
    c = lax.cumsum(log_f, axis=1).transpose(0, 2, 1)
    k_pos = jnp.arange(S)

    def q_block(i):
        start = i * Q_BLOCK
        qb = lax.dynamic_slice_in_dim(q, start, Q_BLOCK, axis=2)
        cb = lax.dynamic_slice_in_dim(c, start, Q_BLOCK, axis=2)
        s = jnp.einsum('bhqd,bhkd->bhqk', qb, k, preferred_element_type=jnp.float32)
        s = s + cb[..., :, None] - c[..., None, :]
        q_pos = start + jnp.arange(Q_BLOCK)
        s = jnp.where(k_pos[None, :] <= q_pos[:, None], s, NEG_INF)
        pr = jax.nn.softmax(s, axis=-1)
        return jnp.einsum('bhqk,bhkd->bhqd', pr.astype(v.dtype), v)

    o = lax.map(q_block, jnp.arange(S // Q_BLOCK))
    o = o.transpose(1, 0, 3, 2, 4).reshape(B, S, D)
    return o @ w_out


def short_conv(h, w_in, conv_w, w_out):
    D = h.shape[-1]
    proj = h @ w_in
    b_gate = proj[..., :D]
    c_gate = proj[..., D:2 * D]
    u = proj[..., 2 * D:]
    z = c_gate * u
    zc = lax.conv_general_dilated(
        z, conv_w[:, None, :].astype(z.dtype), window_strides=(1,),
        padding=[(CONV_WIDTH - 1, 0)],
        dimension_numbers=('NWC', 'WIO', 'NWC'),
        feature_group_count=D)
    return (b_gate * zc) @ w_out


def sq_relu_mlp(h, w_up, w_down):
    return jnp.square(jax.nn.relu(h @ w_up)) @ w_down


def setup_inputs(seed: int = 0) -> dict:
    key = jax.random.key(seed)
    ks = jax.random.split(key, 14)
    f32 = jnp.float32
    nrm = lambda k, shape, scale: jax.random.normal(k, shape, f32) * scale
    x = jax.random.normal(ks[0], (BATCH, SEQ, D_MODEL), f32)
    p = jax.random.normal(ks[1], (DEPTH, BATCH, SEQ, PLE_DIM), f32)
    norm_g = 1.0 + nrm(ks[2], (DEPTH, 6, D_MODEL), 0.05)
    w_attn_in = nrm(ks[3], (N_ATTN, D_MODEL, 3 * D_MODEL + N_HEADS), D_MODEL ** -0.5)
    b_forget = 2.0 + nrm(ks[4], (N_ATTN, N_HEADS), 0.5)
    w_attn_out = nrm(ks[5], (N_ATTN, D_MODEL, D_MODEL), D_MODEL ** -0.5)
    w_conv_in = nrm(ks[6], (N_CONV, D_MODEL, 3 * D_MODEL), D_MODEL ** -0.5)
    conv_w = nrm(ks[7], (N_CONV, CONV_WIDTH, D_MODEL), CONV_WIDTH ** -0.5)
    w_conv_out = nrm(ks[8], (N_CONV, D_MODEL, D_MODEL), D_MODEL ** -0.5)
    w_mlp_up = nrm(ks[9], (DEPTH, D_MODEL, D_FF), D_MODEL ** -0.5)
    w_mlp_down = nrm(ks[10], (DEPTH, D_FF, D_MODEL), D_FF ** -0.5)
    w_ple_proj = nrm(ks[11], (DEPTH, PLE_DIM, D_MODEL), PLE_DIM ** -0.5)
    w_ple_gate = nrm(ks[12], (DEPTH, D_MODEL, D_MODEL), D_MODEL ** -0.5)
    return {"x": x, "p": p, "norm_g": norm_g, "w_attn_in": w_attn_in,
            "b_forget": b_forget, "w_attn_out": w_attn_out, "w_conv_in": w_conv_in,
            "conv_w": conv_w, "w_conv_out": w_conv_out, "w_mlp_up": w_mlp_up,
            "w_mlp_down": w_mlp_down, "w_ple_proj": w_ple_proj, "w_ple_gate": w_ple_gate}


def reference(x, p, norm_g, w_attn_in, b_forget, w_attn_out, w_conv_in, conv_w,
              w_conv_out, w_mlp_up, w_mlp_down, w_ple_proj, w_ple_gate):
    for i in range(DEPTH):
        g = norm_g[i]
        hn = rmsnorm(x, g[0])
        j = i // N_MIXERS
        if i % N_MIXERS == 0:
            m = fox_attention(hn, w_attn_in[j], b_forget[j], w_attn_out[j])
        else:
            m = short_conv(hn, w_conv_in[j], conv_w[j], w_conv_out[j])
        x = x + rmsnorm(m, g[1])
        f = sq_relu_mlp(rmsnorm(x, g[2]), w_mlp_up[i], w_mlp_down[i])
        x = x + rmsnorm(f, g[3])
        gate = jax.nn.sigmoid(rmsnorm(x, g[4]) @ w_ple_gate[i])
        e = (p[i] @ w_ple_proj[i]) * gate
        x = x + rmsnorm(e, g[5])
    return x
```

```cpp
#include <hip/hip_runtime.h>
#include <hip/hip_cooperative_groups.h>
#include <cstdio>
#include <cstdint>
namespace cg = cooperative_groups;
__device__ __forceinline__ int opq_v(int v) { asm volatile("" : "+v"(v)); return v; }
__device__ __forceinline__ int opq_s(int v) { asm volatile("" : "+s"(v)); return v; }
__device__ __forceinline__ float shflx_f(float v, int mask, int lane) { return __int_as_float(__builtin_amdgcn_ds_bpermute((lane ^ mask) << 2, __float_as_int(v))); }
__device__ __forceinline__ int shflx_i(int v, int mask, int lane) { return __builtin_amdgcn_ds_bpermute((lane ^ mask) << 2, v); }
__device__ __forceinline__ float sum_rows4(float v) {
    auto a = __builtin_amdgcn_permlane16_swap(__float_as_uint(v), __float_as_uint(v), false, false); v = __uint_as_float(a[0]) + __uint_as_float(a[1]);
    auto b = __builtin_amdgcn_permlane32_swap(__float_as_uint(v), __float_as_uint(v), false, false); return __uint_as_float(b[0]) + __uint_as_float(b[1]);
}
namespace pg8 {
#define PG8_LAS __attribute__((address_space(3)))
typedef unsigned short bf16_t;
typedef short bf16x8 __attribute__((ext_vector_type(8)));
typedef float f32x4 __attribute__((ext_vector_type(4)));
typedef unsigned u32x4 __attribute__((ext_vector_type(4)));
constexpr int BM = 256, BK = 64, HALF = 128, HTB = HALF * BK * 2  , STAGE_BYTES = 8 * HTB, NXCD = 8, WGM = 8;

__host__ __device__ __forceinline__ int lds_byte(int r, int c) { const int st = (r >> 4) * 2 + (c >> 5), rr = r & 15, cc = c & 31, ob = rr * 64 + cc * 2; return st * 1024 + (ob ^ (((ob >> 9) & 1) << 5)); }
__host__ __device__ __forceinline__ void stage_rc(int b, int& R, int& C) { const int st = b / 1024, sb = b % 1024, swz = sb ^ (((sb >> 9) & 1) << 5); R = (st >> 1) * 16 + swz / 64; C = (st & 1) * 32 + (swz % 64) / 2; }
__host__ __device__ __forceinline__ int perm32(int rho) { const int n = rho >> 4, i = rho & 15; return 8 * (i >> 2) + 4 * n + (i & 3); }

struct Unit { int pm, pn; };
struct Gemm { const bf16_t* A; const bf16_t* Bt; int M, N, K; };

struct StaticOrder {
    int nM, nN, nwg, G, c;
    __host__ __device__ void init(int M, int N, int G_, int c_) { nM = M / BM; nN = N / BM; nwg = nM * nN; G = G_; c = c_; }
    __host__ __device__ bool next(int i, Unit& u) const {
        const long L = (long)i * G + c; if (L >= nwg) return false;
        int wgid = (int)L; { const int q = nwg / NXCD, r = nwg % NXCD, xcd = wgid % NXCD, off = wgid / NXCD; wgid = (xcd < r ? xcd * (q + 1) : r * (q + 1) + (xcd - r) * q) + off; }
        const int nig = WGM * nN, gid = wgid / nig, fm = gid * WGM, gsz = (nM - fm) < WGM ? (nM - fm) : WGM;
        u.pm = fm + ((wgid % nig) % gsz); u.pn = (wgid % nig) / gsz; return true;
    }
    __device__ __forceinline__ void a_ready(const Unit&) const {}
    __device__ __forceinline__ void done(const Unit&) const {}
};

__device__ __forceinline__ unsigned cvt_pk_bf16(float lo, float hi) { unsigned r; asm volatile("v_cvt_pk_bf16_f32 %0, %1, %2" : "=v"(r) : "v"(lo), "v"(hi)); return r; }
typedef float f32x2 __attribute__((ext_vector_type(2)));
typedef float f32x2 __attribute__((ext_vector_type(2)));
template <int ACT  > struct EpiBf16 {
    static constexpr bool PERM = true, AFTER_DRAIN = false, ADJ = true;
    bf16_t* O; int ldc; int split_cols; size_t split_stride; float scale0; float* flog; const float* rs; unsigned* qkm;
    __device__ __forceinline__ void operator()(const f32x4 (&acc)[2][2][4][2], const Unit& u, int wr, int wc, int fr, int fq) const {
        const int row0 = u.pm * BM + wr * 64 + fr; int colt = u.pn * BM; bf16_t* base = O;
        float sc = 1.f; int t = 0;
        if (split_cols) { t = colt / split_cols; base += (size_t)t * split_stride; colt -= t * split_cols; if (t == 0) sc = scale0; }
        if (t == 3) {
            if (wc == 0 && fq < 2) {
#pragma unroll
                for (int ai = 0; ai < 2; ++ai)
#pragma unroll
                    for (int m = 0; m < 4; ++m) { float* rp = flog + (size_t)(row0 + ai * HALF + m * 16) * 16 + 8 * fq; *(f32x4*)rp = acc[ai][0][m][0]; *(f32x4*)(rp + 4) = acc[ai][0][m][1]; }
            }
            return;
        }
        const int col0 = colt + wc * 64 + 8 * fq; const int lane_ = fq * 16 + fr;
        const bool trk = ACT == 0 && qkm != nullptr && t < 2; float cm0 = 0.f, cm1 = 0.f;
        if (ACT == 4 && t >= 1) {
            bf16_t* zb = O + split_stride + (size_t)row0 * ldc + (u.pn - 4) * 128 + wc * 32 + fq * 8;
#pragma unroll
            for (int ai = 0; ai < 2; ++ai)
#pragma unroll
                for (int m = 0; m < 4; ++m) { const float r2 = rs[row0 + ai * HALF + m * 16]; const float rr = r2 * r2;
                    const f32x4 z0 = acc[ai][0][m][0] * acc[ai][0][m][1] * rr, z1 = acc[ai][1][m][0] * acc[ai][1][m][1] * rr;
                    u32x4 w; w.x = cvt_pk_bf16(z0[0], z0[1]); w.y = cvt_pk_bf16(z0[2], z0[3]); w.z = cvt_pk_bf16(z1[0], z1[1]); w.w = cvt_pk_bf16(z1[2], z1[3]);
                    *(u32x4*)(zb + (size_t)(ai * HALF + m * 16) * ldc) = w; }
            return;
        }
        float rsv[2][4];
#pragma unroll
        for (int ai = 0; ai < 2; ++ai)
#pragma unroll
            for (int m = 0; m < 4; ++m) rsv[ai][m] = rs[row0 + ai * HALF + m * 16];
#pragma unroll
        for (int ai = 0; ai < 2; ++ai)
#pragma unroll
            for (int m = 0; m < 4; ++m) { bf16_t* rowp = base + (size_t)(row0 + ai * HALF + m * 16) * ldc + col0;
#pragma unroll
                for (int bj = 0; bj < 2; ++bj) { f32x4 v0 = acc[ai][bj][m][0] * rsv[ai][m], v1 = acc[ai][bj][m][1] * rsv[ai][m];
                    if (ACT == 3) {
#pragma unroll
                        for (int i = 0; i < 4; ++i) { v0[i] = 1.f / (1.f + __expf(-v0[i])); v1[i] = 1.f / (1.f + __expf(-v1[i])); } }
                    if (ACT == 2) {
#pragma unroll
                        for (int i = 0; i < 4; ++i) { const float a = fmaxf(v0[i], 0.f), b = fmaxf(v1[i], 0.f); v0[i] = a * a; v1[i] = b * b; } }
                    v0 = v0 * sc; v1 = v1 * sc; u32x4 w; w.x = cvt_pk_bf16(v0[0], v0[1]); w.y = cvt_pk_bf16(v0[2], v0[3]); w.z = cvt_pk_bf16(v1[0], v1[1]); w.w = cvt_pk_bf16(v1[2], v1[3]);
                    *(u32x4*)(rowp + bj * 32) = w;
                    if (trk) { float q = ((v0[0] * v0[0] + v0[1] * v0[1]) + (v0[2] * v0[2] + v0[3] * v0[3])) + ((v1[0] * v1[0] + v1[1] * v1[1]) + (v1[2] * v1[2] + v1[3] * v1[3]));
                        q = sum_rows4(q);
                        if (bj == 0) cm0 = fmaxf(cm0, q); else cm1 = fmaxf(cm1, q); } } }
        if (trk) {
#pragma unroll
            for (int o = 1; o < 16; o <<= 1) { cm0 = fmaxf(cm0, shflx_f(cm0, o, lane_)); cm1 = fmaxf(cm1, shflx_f(cm1, o, lane_)); }
            if (lane_ == 0) { const int b = (u.pm * BM) >> 14, hd = (colt >> 6) + wc;
                __hip_atomic_fetch_max(qkm + ((b * 16 + hd) * 2 + t) * 2 + 0, __float_as_uint(cm0), __ATOMIC_RELAXED, __HIP_MEMORY_SCOPE_AGENT);
                __hip_atomic_fetch_max(qkm + ((b * 16 + hd) * 2 + t) * 2 + 1, __float_as_uint(cm1), __ATOMIC_RELAXED, __HIP_MEMORY_SCOPE_AGENT); }
        }
    }
};
struct PanelRms {
    unsigned* xbuf;
    unsigned* cnt;
    unsigned* tmo;
    unsigned want; float eps; float* rsout;
    __device__ __forceinline__ void run(const f32x4 (&v)[2][2][4][2], const Unit& u, int wr, int wc, int fr, int fq, PG8_LAS unsigned char* lds, int wid, int lane) const {
        PG8_LAS float* P = (PG8_LAS float*)lds;
        PG8_LAS float* S = (PG8_LAS float*)(lds + 8192);
#pragma unroll
        for (int ai = 0; ai < 2; ++ai)
#pragma unroll
            for (int m = 0; m < 4; ++m) {
                float q = 0.f;
#pragma unroll
                for (int bj = 0; bj < 2; ++bj)
#pragma unroll
                    for (int n = 0; n < 2; ++n) { const f32x4 x = v[ai][bj][m][n]; q += (x[0] * x[0] + x[1] * x[1]) + (x[2] * x[2] + x[3] * x[3]); }
                q = sum_rows4(q);
                if (fq == 0) P[(ai * HALF + wr * 64 + m * 16 + fr) * 4 + wc] = q;
            }
        asm volatile("s_waitcnt lgkmcnt(0)" ::: "memory"); __builtin_amdgcn_s_barrier(); asm volatile("" ::: "memory");
        const int row = wid * 32 + (lane & 31);
        if (lane < 32) {
            const f32x4 p = *(const PG8_LAS f32x4*)(P + row * 4);
            __hip_atomic_store(xbuf + ((size_t)(u.pm * BM + row) * 4 + u.pn), __float_as_uint((p[0] + p[1]) + (p[2] + p[3])), __ATOMIC_RELAXED, __HIP_MEMORY_SCOPE_AGENT);
        }
        asm volatile("s_waitcnt vmcnt(0)" ::: "memory");
        if (lane == 0) __hip_atomic_fetch_add(cnt + 64 * u.pm, 1u, __ATOMIC_RELAXED, __HIP_MEMORY_SCOPE_AGENT);
        if (wid == 0) {
            for (int sp = 0;; ++sp) {
                if ((unsigned)__builtin_amdgcn_readfirstlane(__hip_atomic_load(cnt + 64 * u.pm, __ATOMIC_RELAXED, __HIP_MEMORY_SCOPE_AGENT)) >= want) break;
                if (sp > 65536) { if (lane == 0) __hip_atomic_store(tmo, 1u, __ATOMIC_RELAXED, __HIP_MEMORY_SCOPE_AGENT); break; }
                __builtin_amdgcn_s_sleep(2);
            }
            __builtin_amdgcn_fence(__ATOMIC_ACQUIRE, "agent");
        }
        asm volatile("s_waitcnt vmcnt(0) lgkmcnt(0)" ::: "memory"); __builtin_amdgcn_s_barrier(); asm volatile("" ::: "memory");
        if (lane < 32) {
            const unsigned* slot = xbuf + (size_t)(u.pm * BM + row) * 4; float q = 0.f;
#pragma unroll
            for (int t = 0; t < 4; ++t) q += __uint_as_float(__hip_atomic_load(slot + t, __ATOMIC_RELAXED, __HIP_MEMORY_SCOPE_AGENT));
            const float rstd_ = 1.0f / sqrtf(q * (1.0f / 1024.0f) + eps); S[row] = rstd_;
            if (rsout && u.pn == 0) rsout[u.pm * BM + row] = rstd_;
        }
        asm volatile("s_waitcnt lgkmcnt(0)" ::: "memory"); __builtin_amdgcn_s_barrier(); asm volatile("" ::: "memory");
    }
};
struct EpiRms {
    static constexpr bool PERM = true, AFTER_DRAIN = true, ADJ = false;
    const void* base; void* out; const bf16_t* mul; const float* gA; int ldc; PanelRms st1, st2; int base_f32, out_f32, need_rs;
    __device__ __forceinline__ void fused(f32x4 (&acc)[2][2][4][2], const Unit& u, int wr, int wc, int fr, int fq, PG8_LAS unsigned char* lds, int wid, int lane) const {
        typedef unsigned u32x2v __attribute__((ext_vector_type(2)));
        const PG8_LAS float* S = (const PG8_LAS float*)(lds + 8192);
        const int col0 = u.pn * BM + wc * 32 + 8 * fq;
        const unsigned b0 = (unsigned)((u.pm * BM + wr * 64 + fr) * ldc + col0) * 4u;
#define RMS_OFF(ai, m, bj, n) (b0 + (unsigned)(((ai) * HALF + (m) * 16) * ldc + (bj) * HALF + (n) * 4) * 4u)
#define RMS_UNPK(PK_, lo, hi) do { lo = (f32x4){__uint_as_float((PK_)[0] << 16), __uint_as_float((PK_)[0] & 0xffff0000u), __uint_as_float((PK_)[1] << 16), __uint_as_float((PK_)[1] & 0xffff0000u)}; \
                                   hi = (f32x4){__uint_as_float((PK_)[2] << 16), __uint_as_float((PK_)[2] & 0xffff0000u), __uint_as_float((PK_)[3] << 16), __uint_as_float((PK_)[3] & 0xffff0000u)}; } while (0)
#define RMS_LOADX(ai, m, bj, lo, hi) do { if (base_f32) { lo = *(const f32x4*)((const char*)base + RMS_OFF(ai, m, bj, 0)); hi = *(const f32x4*)((const char*)base + RMS_OFF(ai, m, bj, 1)); } \
                                          else { const u32x4 w_ = *(const u32x4*)((const char*)base + (RMS_OFF(ai, m, bj, 0) >> 1)); RMS_UNPK(w_, lo, hi); } } while (0)
#define RMS_STOREX(ai, m, bj, lo, hi) do { if (out_f32) { *(f32x4*)((char*)out + RMS_OFF(ai, m, bj, 0)) = lo; *(f32x4*)((char*)out + RMS_OFF(ai, m, bj, 1)) = hi; } \
                                           else { u32x4 w_; w_.x = cvt_pk_bf16(lo[0], lo[1]); w_.y = cvt_pk_bf16(lo[2], lo[3]); w_.z = cvt_pk_bf16(hi[0], hi[1]); w_.w = cvt_pk_bf16(hi[2], hi[3]); \
                                                  *(u32x4*)((char*)out + (RMS_OFF(ai, m, bj, 0) >> 1)) = w_; } } while (0)
        if (mul) {
#pragma unroll
            for (int ai = 0; ai < 2; ++ai)
#pragma unroll
                for (int m = 0; m < 4; ++m) {
#pragma unroll
                    for (int bj = 0; bj < 2; ++bj) { const u32x4 w = *(const u32x4*)((const char*)mul + (RMS_OFF(ai, m, bj, 0) >> 1)); f32x4 lo, hi; RMS_UNPK(w, lo, hi);
                        acc[ai][bj][m][0] = acc[ai][bj][m][0] * lo; acc[ai][bj][m][1] = acc[ai][bj][m][1] * hi; }
                    asm volatile("" : "+v"(acc[ai][0][m][0]), "+v"(acc[ai][0][m][1]), "+v"(acc[ai][1][m][0]), "+v"(acc[ai][1][m][1]));
                    if (m & 1) asm volatile("" ::: "memory"); }
        }
        f32x4 pre[2][2][2];
#pragma unroll
        for (int m = 0; m < 2; ++m)
#pragma unroll
            for (int bj = 0; bj < 2; ++bj) RMS_LOADX(0, m, bj, pre[m][bj][0], pre[m][bj][1]);
        f32x4 gpre[2][2];
#pragma unroll
        for (int bj = 0; bj < 2; ++bj)
#pragma unroll
            for (int n = 0; n < 2; ++n) gpre[bj][n] = *(const f32x4*)(gA + col0 + bj * HALF + n * 4);
        st1.run(acc, u, wr, wc, fr, fq, lds, wid, lane);
#pragma unroll
        for (int bj = 0; bj < 2; ++bj)
#pragma unroll
            for (int n = 0; n < 2; ++n) { const f32x4 g = gpre[bj][n];
#pragma unroll
                for (int ai = 0; ai < 2; ++ai)
#pragma unroll
                    for (int m = 0; m < 4; ++m) acc[ai][bj][m][n] = acc[ai][bj][m][n] * g; }
#pragma unroll
        for (int ai = 0; ai < 2; ++ai)
#pragma unroll
            for (int m = 0; m < 4; ++m) { const float sr = S[ai * HALF + wr * 64 + m * 16 + fr];
#pragma unroll
                for (int bj = 0; bj < 2; ++bj) { f32x4 lo, hi;
                    if (ai == 0 && m < 2) { lo = pre[m & 1][bj][0]; hi = pre[m & 1][bj][1]; } else RMS_LOADX(ai, m, bj, lo, hi);
                    acc[ai][bj][m][0] = lo + acc[ai][bj][m][0] * sr; acc[ai][bj][m][1] = hi + acc[ai][bj][m][1] * sr;
                    RMS_STOREX(ai, m, bj, acc[ai][bj][m][0], acc[ai][bj][m][1]); }
                asm volatile("" : "+v"(acc[ai][0][m][0]), "+v"(acc[ai][0][m][1]), "+v"(acc[ai][1][m][0]), "+v"(acc[ai][1][m][1]));
                asm volatile("" ::: "memory"); }
        if (need_rs) st2.run(acc, u, wr, wc, fr, fq, lds, wid, lane);
        asm volatile("s_waitcnt lgkmcnt(0)" ::: "memory"); __builtin_amdgcn_s_barrier(); asm volatile("" ::: "memory");
#undef RMS_OFF
#undef RMS_UNPK
#undef RMS_LOADX
#undef RMS_STOREX
    }
};
struct RoundOrder {
    StaticOrder b; int round;
    __device__ __forceinline__ bool next(int i, Unit& u) const { return i == 0 && b.next(round, u); }
    __device__ __forceinline__ void a_ready(const Unit&) const {}
    __device__ __forceinline__ void done(const Unit&) const {}
};

template <class Epi, class Sched, bool ALIGN_EPI = false, bool SP2 = false>
__device__ __forceinline__ void gemm_phase(PG8_LAS unsigned char* lds, const Gemm g, const Sched& S, const Epi& E) {
    const int tid = opq_v((int)threadIdx.x), wid = __builtin_amdgcn_readfirstlane(tid >> 6), lane = tid & 63, wr = wid >> 2, wc = wid & 3, fr = lane & 15, fq = lane >> 4;
    const int K = g.K, nt = K / BK;
    unsigned voffA[2], voffB[2];
#pragma unroll
    for (int i = 0; i < 2; ++i) { int R, C; stage_rc(tid * 16 + i * 8192, R, C); const int Rb = Epi::ADJ ? (64 * (R >> 5) + perm32(R & 31)) : Epi::PERM ? ((R & ~31) + perm32(R & 31)) : R;
        voffA[i] = (unsigned)(R * K + C) * 2u; voffB[i] = (unsigned)(Rb * K + C) * 2u; }
    const size_t kstep = (size_t)(BK * 2);
    const size_t hstep = (size_t)HALF * K * 2;
    const size_t tstep = 2 * hstep;
    const size_t bhstep = Epi::ADJ ? (size_t)32 * K * 2 : hstep;
    const unsigned ldsw = (unsigned)wid * 1024u;
    const int aoff = lds_byte(wr * 64 + fr, fq * 8), boff = lds_byte(wc * 32 + fr, fq * 8);
#define PG8_SA(b, h) (((b) * 2 + (h)) * HTB)
#define PG8_SB(b, h) ((4 + (b) * 2 + (h)) * HTB)
#define PG8_STAGE(bufoff, gbase, voff) do { _Pragma("unroll") for (int _i = 0; _i < 2; ++_i) \
        __builtin_amdgcn_global_load_lds((const unsigned*)((const char*)(gbase) + (voff)[_i]), (PG8_LAS unsigned*)(lds + (bufoff) + ldsw + _i * 8192), 16, 0, 0); } while (0)
#define PG8_LDA(dst, b, h) do { _Pragma("unroll") for (int m = 0; m < 4; ++m) _Pragma("unroll") for (int k = 0; k < 2; ++k) dst[m][k] = *(const PG8_LAS bf16x8*)(lds + PG8_SA(b, h) + aoff + m * 2048 + k * 1024); } while (0)
#define PG8_LDB(dst, b, h) do { _Pragma("unroll") for (int n = 0; n < 2; ++n) _Pragma("unroll") for (int k = 0; k < 2; ++k) dst[n][k] = *(const PG8_LAS bf16x8*)(lds + PG8_SB(b, h) + boff + n * 2048 + k * 1024); } while (0)
#define PG8_MMA(ai, bj, At, Bt) do { __builtin_amdgcn_s_setprio(1); _Pragma("unroll") for (int m = 0; m < 4; ++m) _Pragma("unroll") for (int n = 0; n < 2; ++n) _Pragma("unroll") for (int k = 0; k < 2; ++k) \
        acc[ai][bj][m][n] = __builtin_amdgcn_mfma_f32_16x16x32_bf16(Bt[n][k], At[m][k], acc[ai][bj][m][n], 0, 0, 0); __builtin_amdgcn_s_setprio(0); } while (0)
#define PG8_WAIT_V(n) asm volatile("s_waitcnt vmcnt(" #n ")" ::: "memory")
#define PG8_WAIT_L(n) asm volatile("s_waitcnt lgkmcnt(" #n ")" ::: "memory")
#define PG8_BAR __builtin_amdgcn_s_barrier()
#define PG8_SCHED __builtin_amdgcn_sched_barrier(0)
    Unit cur, nxt; int ui = 0;
    if (!S.next(0, cur)) return;
    f32x4 acc[2][2][4][2];
#pragma unroll
    for (int a = 0; a < 2; ++a)
#pragma unroll
        for (int b = 0; b < 2; ++b)
#pragma unroll
            for (int m = 0; m < 4; ++m)
#pragma unroll
                for (int n = 0; n < 2; ++n) acc[a][b][m][n] = (f32x4){0.f, 0.f, 0.f, 0.f};
    bf16x8 At[4][2], B0[2][2], B1[2][2];
    const char* cA = (const char*)g.A + (size_t)cur.pm * tstep; const char* cB = (const char*)g.Bt + (size_t)cur.pn * tstep;
    S.a_ready(cur);
    if constexpr (SP2) {
        PG8_STAGE(PG8_SB(0, 0), cB, voffB); PG8_STAGE(PG8_SB(0, 1), cB + bhstep, voffB); PG8_STAGE(PG8_SA(0, 0), cA, voffA); PG8_STAGE(PG8_SA(0, 1), cA + hstep, voffA);
        if (wr == 1) PG8_BAR;
        PG8_WAIT_V(2); PG8_BAR;
        PG8_STAGE(PG8_SB(1, 0), cB + kstep, voffB); PG8_STAGE(PG8_SA(1, 0), cA + kstep, voffA); PG8_STAGE(PG8_SB(1, 1), cB + bhstep + kstep, voffB);
        PG8_WAIT_V(6); PG8_BAR;
    } else {
        PG8_STAGE(PG8_SB(0, 0), cB, voffB); PG8_STAGE(PG8_SA(0, 0), cA, voffA); PG8_STAGE(PG8_SB(0, 1), cB + bhstep, voffB); PG8_STAGE(PG8_SA(0, 1), cA + hstep, voffA);
        if (wr == 1) PG8_BAR;
        PG8_WAIT_V(4); PG8_BAR;
        PG8_STAGE(PG8_SB(1, 0), cB + kstep, voffB); PG8_STAGE(PG8_SA(1, 0), cA + kstep, voffA); PG8_STAGE(PG8_SB(1, 1), cB + bhstep + kstep, voffB);
        PG8_WAIT_V(6); PG8_BAR;
    }
    for (;;) {
        const bool has_next = S.next(ui + 1, nxt);
        const char* nA = has_next ? (const char*)g.A + (size_t)nxt.pm * tstep : cA; const char* nB = has_next ? (const char*)g.Bt + (size_t)nxt.pn * tstep : cB;
        for (int t = 0; t < nt; t += 2) {
            const bool last = (t == nt - 2);
            const char* a1 = cA + (size_t)(t + 1) * kstep;
            const char* a2 = last ? nA : cA + (size_t)(t + 2) * kstep; const char* b2 = last ? nB : cB + (size_t)(t + 2) * kstep;
            const char* a3 = a2 + kstep; const char* b3 = b2 + kstep;
            if (last && has_next) S.a_ready(nxt);
            if constexpr (SP2) {
            PG8_LDB(B0, 0, 0); PG8_LDB(B1, 0, 1); PG8_SCHED; PG8_LDA(At, 0, 0); PG8_STAGE(PG8_SA(1, 1), a1 + hstep, voffA);
            PG8_WAIT_V(8); PG8_WAIT_L(0); PG8_BAR; PG8_MMA(0, 0, At, B0); PG8_MMA(0, 1, At, B1); PG8_BAR; PG8_SCHED;
            PG8_LDA(At, 0, 1); PG8_STAGE(PG8_SB(0, 0), b2, voffB); PG8_STAGE(PG8_SB(0, 1), b2 + bhstep, voffB); PG8_STAGE(PG8_SA(0, 0), a2, voffA);
            PG8_WAIT_V(8); PG8_WAIT_L(0); PG8_BAR; PG8_MMA(1, 0, At, B0); PG8_MMA(1, 1, At, B1); PG8_BAR; PG8_SCHED;
            PG8_LDB(B0, 1, 0); PG8_LDB(B1, 1, 1); PG8_SCHED; PG8_LDA(At, 1, 0); PG8_STAGE(PG8_SA(0, 1), a2 + hstep, voffA);
            PG8_WAIT_V(8); PG8_WAIT_L(0); PG8_BAR; PG8_MMA(0, 0, At, B0); PG8_MMA(0, 1, At, B1); PG8_BAR; PG8_SCHED;
            PG8_LDA(At, 1, 1); PG8_STAGE(PG8_SB(1, 0), b3, voffB); PG8_STAGE(PG8_SB(1, 1), b3 + bhstep, voffB); PG8_STAGE(PG8_SA(1, 0), a3, voffA);
            PG8_WAIT_V(8); PG8_WAIT_L(0); PG8_BAR; PG8_MMA(1, 0, At, B0); PG8_MMA(1, 1, At, B1); PG8_BAR; PG8_SCHED;
            } else {
            PG8_LDB(B0, 0, 0); PG8_SCHED; PG8_LDA(At, 0, 0); PG8_STAGE(PG8_SA(1, 1), a1 + hstep, voffA);
            PG8_WAIT_L(8); PG8_BAR; PG8_WAIT_L(0); PG8_MMA(0, 0, At, B0); PG8_BAR; PG8_SCHED;
            PG8_LDB(B1, 0, 1); PG8_STAGE(PG8_SB(0, 0), b2, voffB);
            PG8_BAR; PG8_WAIT_L(0); PG8_MMA(0, 1, At, B1); PG8_BAR;
            PG8_LDA(At, 0, 1); PG8_STAGE(PG8_SA(0, 0), a2, voffA);
            PG8_BAR; PG8_WAIT_L(0); PG8_MMA(1, 0, At, B0); PG8_BAR; PG8_SCHED;
            PG8_STAGE(PG8_SB(0, 1), b2 + bhstep, voffB);
            PG8_WAIT_V(6); PG8_BAR; PG8_MMA(1, 1, At, B1); PG8_BAR;
            PG8_LDB(B0, 1, 0); PG8_SCHED; PG8_LDA(At, 1, 0); PG8_STAGE(PG8_SA(0, 1), a2 + hstep, voffA);
            PG8_WAIT_L(8); PG8_BAR; PG8_WAIT_L(0); PG8_MMA(0, 0, At, B0); PG8_BAR; PG8_SCHED;
            PG8_LDB(B1, 1, 1); PG8_STAGE(PG8_SB(1, 0), b3, voffB);
            PG8_BAR; PG8_WAIT_L(0); PG8_MMA(0, 1, At, B1); PG8_BAR;
            PG8_LDA(At, 1, 1); PG8_STAGE(PG8_SA(1, 0), a3, voffA);
            PG8_BAR; PG8_WAIT_L(0); PG8_MMA(1, 0, At, B0); PG8_BAR; PG8_SCHED;
            PG8_STAGE(PG8_SB(1, 1), b3 + bhstep, voffB);
            PG8_WAIT_V(6); PG8_BAR; PG8_MMA(1, 1, At, B1); PG8_BAR;
            }
        }
        if constexpr (ALIGN_EPI) { if (wr == 0) PG8_BAR; }
        if constexpr (!Epi::AFTER_DRAIN) { E(acc, cur, wr, wc, fr, fq); S.done(cur); }
        if (!has_next) break;
#pragma unroll
        for (int a = 0; a < 2; ++a)
#pragma unroll
            for (int b = 0; b < 2; ++b)
#pragma unroll
                for (int m = 0; m < 4; ++m)
#pragma unroll
                    for (int n = 0; n < 2; ++n) acc[a][b][m][n] = (f32x4){0.f, 0.f, 0.f, 0.f};
        cur = nxt; cA = nA; cB = nB; ++ui;
        if constexpr (ALIGN_EPI) { if (wr == 1) PG8_BAR; }
    }
    PG8_WAIT_V(0);
    if constexpr (!ALIGN_EPI) { if (wr == 0) PG8_BAR; }
    PG8_BAR;
    if constexpr (Epi::AFTER_DRAIN) { E.fused(acc, cur, wr, wc, fr, fq, lds, wid, lane); S.done(cur); }
#undef PG8_SA
#undef PG8_SB
#undef PG8_STAGE
#undef PG8_LDA
#undef PG8_LDB
#undef PG8_MMA
#undef PG8_WAIT_V
#undef PG8_WAIT_L
#undef PG8_BAR
#undef PG8_SCHED
}
}
#include <hip/hip_bf16.h>
#include <cmath>
namespace attn_body {
using bf16=__hip_bfloat16;
using bf16x8=__attribute__((ext_vector_type(8)))short;
using s16x4=__attribute__((ext_vector_type(4)))short;
using f32x16=__attribute__((ext_vector_type(16)))float;
using u32x4=__attribute__((ext_vector_type(4)))unsigned;
constexpr int BATCH=2,NHEAD=16,SEQ=16384,D=64,DM=NHEAD*D;
constexpr int NW=8,QBLK=32,QB=QBLK*NW,KVBLK=64,NQB=SEQ/QB;
constexpr int ATTN_PITCH=DM, ATTN_UNIT_ROWS=QB;
__device__ __forceinline__ int crow(int r,int hi){return (r&3)+8*(r>>2)+4*hi;}
#define SBAR() __builtin_amdgcn_sched_barrier(0)
__device__ __forceinline__ void cmask(f32x16&p0,f32x16&p1,int jb,int qrel,int hi){
  const float NEG=__int_as_float(opq_s((int)0xff800000)); int kb=64*jb+4*hi;
  #pragma unroll
  for(int r=0;r<16;++r){int kv=kb+(r&3)+8*(r>>2); if(kv>qrel)p0[r]=NEG; if(kv+32>qrel)p1[r]=NEG;}
}

constexpr int NSLOT=3, SLOTB=8192;
constexpr int LDS_K=0, LDS_V=NSLOT*SLOTB, LDS_WS=2*NSLOT*SLOTB, LDS_CK=LDS_WS+NW*64*4, LDS_OST=LDS_CK, LDS_BYTES=LDS_CK+65536;
constexpr float C2=0.125f*1.4426950408889634f;
__device__ __forceinline__ void glds16(const void*gsrc,unsigned lds_dst){unsigned keep;
  asm volatile("s_mov_b32 %0, m0\n\ts_mov_b32 m0, %2\n\ts_nop 0\n\tglobal_load_lds_dwordx4 %1, off\n\ts_mov_b32 m0, %0":"=&s"(keep):"v"(gsrc),"s"(lds_dst):"memory");}
__device__ __forceinline__ float max3f(float a,float b,float c){float r;asm("v_max3_f32 %0, %1, %2, %3":"=v"(r):"v"(a),"v"(b),"v"(c));return r;}
__device__ __forceinline__ float max2f(float a,float b){float r;asm("v_max_f32_e32 %0, %1, %2":"=v"(r):"v"(a),"v"(b));return r;}
__device__ __forceinline__ float fadd_s(float a,float b){float r;asm("v_add_f32_e32 %0, %1, %2":"=v"(r):"v"(a),"v"(b));return r;}
__device__ __forceinline__ float fsub_s(float a,float b){float r;asm("v_sub_f32_e32 %0, %1, %2":"=v"(r):"v"(a),"v"(b));return r;}
typedef float f32x2_t __attribute__((ext_vector_type(2))); typedef __bf16 bf16x2_t __attribute__((ext_vector_type(2)));
__device__ __forceinline__ unsigned cvtpk_s(float lo,float hi){f32x2_t v={lo,hi};bf16x2_t b=__builtin_convertvector(v,bf16x2_t);return __builtin_bit_cast(unsigned,b);}
#define WAIT_BAR(N) asm volatile("s_waitcnt vmcnt(" #N ") lgkmcnt(0)\n\ts_barrier":::"memory")

__device__ __forceinline__ void qkt(f32x16&p0,f32x16&p1,const char*Kslot,const bf16x8*qr,const f32x16&negm,int r32,int hi){
  const char*kb=Kslot+hi*1024+r32*16;
  #pragma unroll
  for(int d0=0;d0<4;++d0){
    const bf16x8 b0=*reinterpret_cast<const bf16x8*>(kb+d0*2048);
    const bf16x8 b1=*reinterpret_cast<const bf16x8*>(kb+d0*2048+512);
    if(d0==0){p0=__builtin_amdgcn_mfma_f32_32x32x16_bf16(b0,qr[0],negm,0,0,0);p1=__builtin_amdgcn_mfma_f32_32x32x16_bf16(b1,qr[0],negm,0,0,0);}
    else{p0=__builtin_amdgcn_mfma_f32_32x32x16_bf16(b0,qr[d0],p0,0,0,0);p1=__builtin_amdgcn_mfma_f32_32x32x16_bf16(b1,qr[d0],p1,0,0,0);}}
}
typedef __attribute__((address_space(3))) const char* lds_cptr;
typedef short v4i16_t __attribute__((ext_vector_type(4)));
__device__ __forceinline__ void kload8(bf16x8*kf,lds_cptr kp){
  kf[0]=*(const __attribute__((address_space(3))) bf16x8*)(kp);      kf[1]=*(const __attribute__((address_space(3))) bf16x8*)(kp+512);
  kf[2]=*(const __attribute__((address_space(3))) bf16x8*)(kp+2048); kf[3]=*(const __attribute__((address_space(3))) bf16x8*)(kp+2560);
  kf[4]=*(const __attribute__((address_space(3))) bf16x8*)(kp+4096); kf[5]=*(const __attribute__((address_space(3))) bf16x8*)(kp+4608);
  kf[6]=*(const __attribute__((address_space(3))) bf16x8*)(kp+6144); kf[7]=*(const __attribute__((address_space(3))) bf16x8*)(kp+6656);
}
__device__ __forceinline__ void kload2(bf16x8*kf,lds_cptr kp,int j){ kf[2*j]=*(const __attribute__((address_space(3))) bf16x8*)(kp+j*2048); kf[2*j+1]=*(const __attribute__((address_space(3))) bf16x8*)(kp+j*2048+512); }
__device__ __forceinline__ s16x4 vtr(lds_cptr p){ return __builtin_bit_cast(s16x4,__builtin_amdgcn_ds_read_tr16_b64_v4i16((__attribute__((address_space(3))) v4i16_t*)p)); }
__device__ __forceinline__ float rowmax(const f32x16&p0,const f32x16&p1){
  float a=max3f(p0[0],p0[1],p1[0]),b=max3f(p0[2],p0[3],p1[1]);a=max3f(a,p1[2],p1[3]);
  #pragma unroll
  for(int r=4;r<16;r+=4){a=max3f(a,p0[r],p0[r+1]);b=max3f(b,p0[r+2],p0[r+3]);a=max3f(a,p1[r],p1[r+1]);b=max3f(b,p1[r+2],p1[r+3]);}
  const float m=max2f(a,b);
  auto rr=__builtin_amdgcn_permlane32_swap(__float_as_uint(m),__float_as_uint(m),false,false);
  return max2f(__uint_as_float(rr[0]),__uint_as_float(rr[1]));
}
__device__ __forceinline__ void pv(f32x16*o,int vb,bf16x8 pa0,bf16x8 pa1,bf16x8 pa2,bf16x8 pa3){
  #pragma unroll
  for(int d0=0;d0<2;++d0){s16x4 lo[4],hi[4];
    #pragma unroll
    for(int ks=0;ks<4;++ks){
      asm volatile("ds_read_b64_tr_b16 %0,%1 offset:%c2":"=&v"(lo[ks]):"v"(vb),"i"(d0*4096+ks*1024):"memory");
      asm volatile("ds_read_b64_tr_b16 %0,%1 offset:%c2":"=&v"(hi[ks]):"v"(vb),"i"(d0*4096+ks*1024+512):"memory");}
    asm volatile("s_waitcnt lgkmcnt(0)":::"memory");SBAR();
    #define PK(k) (bf16x8){lo[k][0],lo[k][1],lo[k][2],lo[k][3],hi[k][0],hi[k][1],hi[k][2],hi[k][3]}
    o[d0]=__builtin_amdgcn_mfma_f32_32x32x16_bf16(pa0,PK(0),o[d0],0,0,0);
    o[d0]=__builtin_amdgcn_mfma_f32_32x32x16_bf16(pa1,PK(1),o[d0],0,0,0);
    o[d0]=__builtin_amdgcn_mfma_f32_32x32x16_bf16(pa2,PK(2),o[d0],0,0,0);
    o[d0]=__builtin_amdgcn_mfma_f32_32x32x16_bf16(pa3,PK(3),o[d0],0,0,0);
    #undef PK
  }
}
constexpr float SKIP_T=40.f;
#ifndef ATTN_STORE16
#define ATTN_STORE16(p,v) (*(u32x4*)(p)=(v))
#endif
typedef float f32x4a __attribute__((ext_vector_type(4)));
__device__ __forceinline__ void fox_unit(int b,int h,int qb,const bf16*Q,const bf16*__restrict__ K,const bf16*__restrict__ V,bf16*O,const float*__restrict__ c2h,float bnd,char*shm){
  const int tid=opq_v((int)threadIdx.x),lane=tid&63,r32=lane&31,hi=lane>>5; const int wid=__builtin_amdgcn_readfirstlane(tid>>6);
  const long rowbase=(long)b*SEQ; const int q0=qb*QB;
  const bf16*Qw=Q+(rowbase+q0+wid*QBLK)*DM+h*D;
  const bf16*Kh=K+rowbase*DM+h*D,*Vh=V+rowbase*DM+h*D;
  const unsigned lds0=(unsigned)(uintptr_t)shm;
  float*wsf=(float*)(shm+LDS_WS)+wid*64;
  float*CK=(float*)(shm+LDS_CK);
  const bf16*ksrc=Kh+(long)lane*DM+wid*8;
  const bf16*vsrc=Vh+(long)(16*(wid&3)+(lane>>2))*DM+(wid>>2)*32+(lane&3)*8;
  const unsigned kdst=lds0+LDS_K+wid*1024, vdst=lds0+LDS_V+wid*1024;
  #define DMA_K(t,slot) glds16(ksrc+(long)(t)*KVBLK*DM,(unsigned)__builtin_amdgcn_readfirstlane(kdst+(slot)))
  #define DMA_V(t,slot) glds16(vsrc+(long)(t)*KVBLK*DM,(unsigned)__builtin_amdgcn_readfirstlane(vdst+(slot)))
  const int vb0=(int)(lds0+LDS_V)+((lane>>4)&1)*32+(lane&3)*8+(4*hi+((lane&15)>>2))*64;
  const char*Kbase=shm+LDS_K;
  const int NT=(q0+QB)/KVBLK;
  const float thr=c2h[q0]+2.f*bnd+SKIP_T;
  int tl=NT-4;
  for(int t=lane;t<NT-4;t+=64){ if(!(c2h[64*t+63]>thr)) tl=min(tl,t); }
  #pragma unroll
  for(int o_=32;o_>=1;o_>>=1) tl=min(tl,shflx_i(tl,o_,lane));
  tl=__builtin_amdgcn_readfirstlane(tl);
  const int n=NT-tl;
  DMA_K(NT-1,0);DMA_V(NT-1,0);
  for(int i=tid*4;i<64*n;i+=NW*64*4) *(f32x4a*)(CK+i)=*(const f32x4a*)(c2h+64*tl+i);
  bf16x8 qr[4];
  #pragma unroll
  for(int d0=0;d0<4;++d0)qr[d0]=*reinterpret_cast<const bf16x8*>(&Qw[(long)r32*DM+d0*16+hi*8]);
  const float cq=c2h[q0+wid*QBLK+r32];
  float mhat=-bnd,l_reg=0.f;f32x16 o[2];o[0]=f32x16{};o[1]=f32x16{};f32x16 negm;
  #pragma unroll
  for(int r=0;r<16;++r)negm[r]=cq-mhat;
  const int qrel=wid*QBLK+r32;
  int sl=0,sl_n=SLOTB;
  for(int it=0;it<n;++it){
    const int t=NT-1-it;
    if(it+1<n){ DMA_K(t-1,sl_n); DMA_V(t-1,sl_n); WAIT_BAR(2); } else { WAIT_BAR(0); }
    if(!(it<4 && 64*(3-it)>32*wid+31)){
    f32x16 p0,p1;
    qkt(p0,p1,Kbase+sl,qr,negm,r32,hi);
    { const float*ckt=CK+(t-tl)*64+4*hi;
      #pragma unroll
      for(int g=0;g<4;++g){ const f32x4a ca=*(const f32x4a*)(ckt+8*g), cb=*(const f32x4a*)(ckt+32+8*g);
        #pragma unroll
        for(int i=0;i<4;++i){ p0[4*g+i]-=ca[i]; p1[4*g+i]-=cb[i]; } } }
    if(it<4)cmask(p0,p1,3-it,qrel,hi);
    float rm;
    { float a=__builtin_fmaxf(p0[0],p1[0]);
      #pragma unroll
      for(int r=1;r<16;++r)a=__builtin_fmaxf(a,__builtin_fmaxf(p0[r],p1[r]));
      auto rr=__builtin_amdgcn_permlane32_swap(__float_as_uint(a),__float_as_uint(a),false,false);
      rm=__builtin_fmaxf(__uint_as_float(rr[0]),__uint_as_float(rr[1])); }
    const float mnew=__builtin_fmaxf(mhat,rm), dl=mnew-mhat;
    if(__any(dl>0.f)){
      const float f=__builtin_amdgcn_exp2f(-dl); l_reg*=f; if(hi==0)wsf[r32]=f;
      asm volatile("s_waitcnt lgkmcnt(0)":::"memory");
      #pragma unroll
      for(int d_=0;d_<2;++d_)
        #pragma unroll
        for(int r=0;r<16;++r)o[d_][r]*=wsf[crow(r,hi)];
      mhat=mnew;
      #pragma unroll
      for(int r=0;r<16;++r){negm[r]=cq-mhat;p0[r]-=dl;p1[r]-=dl;}
    }
    float sacc=0.f;
    #pragma unroll
    for(int r=0;r<16;++r){p0[r]=__builtin_amdgcn_exp2f(p0[r]);p1[r]=__builtin_amdgcn_exp2f(p1[r]);sacc+=p0[r]+p1[r];}
    l_reg+=sacc;
    { u32x4 pw0,pw1,pw2,pw3;
      #define PKW(P,B) cvtpk_s(P[B],P[B+1])
      pw0=(u32x4){PKW(p0,0),PKW(p0,2),PKW(p0,4),PKW(p0,6)};pw1=(u32x4){PKW(p0,8),PKW(p0,10),PKW(p0,12),PKW(p0,14)};pw2=(u32x4){PKW(p1,0),PKW(p1,2),PKW(p1,4),PKW(p1,6)};pw3=(u32x4){PKW(p1,8),PKW(p1,10),PKW(p1,12),PKW(p1,14)};
      #undef PKW
      SBAR(); pv(o,vb0+sl,__builtin_bit_cast(bf16x8,pw0),__builtin_bit_cast(bf16x8,pw1),__builtin_bit_cast(bf16x8,pw2),__builtin_bit_cast(bf16x8,pw3)); }
    }
    sl=sl_n; sl_n=(sl_n==(NSLOT-1)*SLOTB)?0:sl_n+SLOTB;
  }
  asm volatile("s_waitcnt lgkmcnt(0)\n\ts_barrier":::"memory");
  {auto rr=__builtin_amdgcn_permlane32_swap(__float_as_uint(l_reg),__float_as_uint(l_reg),false,false);l_reg=__uint_as_float(rr[0])+__uint_as_float(rr[1]);}
  if(hi==0)wsf[32+r32]=l_reg;asm volatile("s_waitcnt lgkmcnt(0)":::"memory");
  float rli[16];
  #pragma unroll
  for(int r=0;r<16;++r)rli[r]=__builtin_amdgcn_rcpf(wsf[32+crow(r,hi)]);
  bf16*Ow=O+(rowbase+q0+wid*QBLK)*DM+h*D;
  { bf16*stg=(bf16*)(shm+LDS_OST)+wid*2048;
    #pragma unroll
    for(int r=0;r<16;++r){const int orow=crow(r,hi);
      #pragma unroll
      for(int d0=0;d0<2;++d0)stg[orow*64+d0*32+r32]=__float2bfloat16(o[d0][r]*rli[r]);}
    asm volatile("s_waitcnt lgkmcnt(0)":::"memory");
    #pragma unroll
    for(int i=0;i<4;++i){const int row=i*8+(lane>>3),ch=lane&7; const u32x4 v=*(const u32x4*)(stg+row*64+ch*8); ATTN_STORE16(Ow+(long)row*DM+ch*8,v);} }
  asm volatile("s_waitcnt lgkmcnt(0)\n\ts_barrier":::"memory");
  #undef DMA_K
  #undef DMA_V
}
constexpr int ATTN_LDS_BYTES=LDS_BYTES;
#undef SBAR
#undef WAIT_BAR
}
constexpr int NWAVES = 8;
constexpr int BATCH = 2, SEQ = 16384, D = 1024, H = 16, HD = 64, FF = 4096, PLE = 256, DEPTH = 4;
constexpr int M = BATCH * SEQ;
constexpr int NIN_ATT = 3 * D + H;
constexpr float RMS_EPS = 1e-6f;
constexpr float LOG2E = 1.4426950408889634f;
constexpr size_t MiB = 1u << 20;
constexpr size_t WS_CTL = 0, CTL_ZERO_BYTES = 1 * MiB;
constexpr size_t WS_C2 = 1 * MiB, WS_FLOG = 3 * MiB;
constexpr size_t WS_X1 = 5 * MiB, WS_X2 = 6 * MiB, WS_RS = 7 * MiB;
constexpr size_t WS_WIN = 8 * MiB, WS_WOUT = 15 * MiB, WS_WUP = 17 * MiB, WS_WDN = 25 * MiB, WS_WG = 33 * MiB, WS_WP = 35 * MiB, WS_WALT = 3 * MiB;
constexpr size_t WS_PB = 40 * MiB, WS_PB2 = 56 * MiB  , WS_QO = 120 * MiB, WS_K = 184 * MiB, WS_V = 248 * MiB, WS_H = 120 * MiB, WS_Y = 376 * MiB  , WS_XB = 440 * MiB  , WS_END = 504 * MiB;
constexpr int CW_TMO = 0, CW_SEAM = 16384, SEAM_BANK = 128 * 64;
constexpr int CW_ATTQ = 2048;
constexpr int CW_QKMAX = 1024;
constexpr int RING_OFF = 0, RING_BYTES = 131072, LDS_BYTES = 147456;
static_assert(attn_body::ATTN_LDS_BYTES <= RING_BYTES, "attention LDS");

#define GAS __attribute__((address_space(1)))
#define LAS __attribute__((address_space(3)))
typedef unsigned short bf16;
typedef unsigned v4u __attribute__((ext_vector_type(4)));
typedef float f32x4 __attribute__((ext_vector_type(4)));
#define LDS_WAIT() asm volatile("s_waitcnt lgkmcnt(0)" ::: "memory")
__device__ __forceinline__ unsigned f2bf(float f) { unsigned u = __builtin_bit_cast(unsigned, f); return (u + 0x7fffu + ((u >> 16) & 1u)) >> 16; }
__device__ __forceinline__ unsigned pk2(float lo, float hi) { return f2bf(lo) | (f2bf(hi) << 16); }
__device__ __forceinline__ float wave_sum(float v) {
#pragma unroll
    for (int o = 1; o < 64; o <<= 1) v += __shfl_xor(v, o);
    return v;
}
__device__ __forceinline__ void transpose_item(const float* W, int K, int N, int ldn, bf16* WT, int row_off, LAS float* scr, int item, int lane, const float* g = nullptr, int cumode = 0) {
    const int nblk = N / 32, kb = item / nblk, nb = item % nblk, k0 = 64 * kb, n0 = 32 * nb;
    int srcc = n0 + 4 * (lane & 7);
    if (cumode && srcc >= 1024) { const int cu = srcc - 1024, col = cu & 255; srcc = (((col >> 2) & 1) ? 2048 : 1024) + (cu >> 8) * 128 + (col >> 6) * 32 + ((col >> 3) & 3) * 8 + ((col >> 5) & 1) * 4; }
    { f32x4 t[8];
#pragma unroll
      for (int i = 0; i < 8; ++i) t[i] = *(const GAS f32x4*)(W + (size_t)(k0 + 8 * i + (lane >> 3)) * ldn + srcc);
      if (g) {
#pragma unroll
        for (int i = 0; i < 8; ++i) t[i] = t[i] * g[k0 + 8 * i + (lane >> 3)]; }
#pragma unroll
      for (int i = 0; i < 8; ++i) { LAS float* d = scr + (8 * i + (lane >> 3)) * 33 + 4 * (lane & 7); d[0] = t[i].x; d[1] = t[i].y; d[2] = t[i].z; d[3] = t[i].w; } }
    LDS_WAIT(); asm volatile("" ::: "memory");
    const int c = lane & 7;
#pragma unroll
    for (int j = 0; j < 4; ++j) { const int n = (lane >> 3) + 8 * j; const LAS float* s = scr + (8 * c) * 33 + n;
        v4u o; o.x = pk2(s[0 * 33], s[1 * 33]); o.y = pk2(s[2 * 33], s[3 * 33]); o.z = pk2(s[4 * 33], s[5 * 33]); o.w = pk2(s[6 * 33], s[7 * 33]);
        *(GAS v4u*)(WT + (size_t)(row_off + n0 + n) * K + k0 + 8 * c) = o; }
    LDS_WAIT(); asm volatile("" ::: "memory");
}
struct Args { const float* in[13]; float* out; unsigned char* ws; };
typedef volatile LAS unsigned long long* PTab;
__device__ __forceinline__ unsigned long long ptab_raw(PTab PT, int i) { const unsigned a_ = (unsigned)opq_s((int)(unsigned)(size_t)PT + 8 * i);
    const unsigned long long v = *(volatile LAS unsigned long long*)a_; return ((unsigned long long)(unsigned)__builtin_amdgcn_readfirstlane((int)(unsigned)(v >> 32)) << 32) | (unsigned)__builtin_amdgcn_readfirstlane((int)(unsigned)v); }
__device__ __forceinline__ const float* ptab_in(PTab PT, int i) { return (const float*)(const GAS float*)ptab_raw(PT, i); }
__device__ __forceinline__ unsigned char* ptab_ws(PTab PT) { return (unsigned char*)(GAS unsigned char*)ptab_raw(PT, 14); }
__device__ __forceinline__ float* ptab_out(PTab PT) { return (float*)(GAS float*)ptab_raw(PT, 13); }
__device__ __forceinline__ void convert_layer(PTab PT, int li, LAS unsigned char* lds, int gw, int NGW, int wave, int lane_, int part = 0) {
    const int lane = opq_v(lane_);
    LAS float* scr = (LAS float*)(lds + RING_OFF + wave * 16384);
    unsigned char* ws = ptab_ws(PT); const int j = li >> 1; const bool att = (li & 1) == 0;
    const float* Win = att ? ptab_in(PT, 3) + (size_t)j * D * NIN_ATT : ptab_in(PT, 6) + (size_t)j * D * 3 * D; const int ldin = att ? NIN_ATT : 3 * D;
    const float* Wout = att ? ptab_in(PT, 5) + (size_t)j * D * D : ptab_in(PT, 8) + (size_t)j * D * D;
    const float* Wup = ptab_in(PT, 9) + (size_t)li * D * FF; const float* Wdn = ptab_in(PT, 10) + (size_t)li * FF * D;
    const float* Wp = ptab_in(PT, 11) + (size_t)li * PLE * D; const float* Wg = ptab_in(PT, 12) + (size_t)li * D * D;
    const float* gn = ptab_in(PT, 2) + (size_t)li * 6 * D;
    constexpr int I_IN = (D / 64) * (3 * D / 32), I_O = (D / 64) * (D / 32), I_UP = (D / 64) * (FF / 32), I_DN = (FF / 64) * (D / 32), I_G = I_O, I_P = (PLE / 64) * (D / 32), I_F = D / 64;
    const int nF = att ? I_F : 0, NITEMS = I_IN + nF + I_O + I_UP + I_DN + I_G + I_P;
    const int it_lo = part == 2 ? I_IN + nF : 0, it_hi = part == 1 ? I_IN + nF : NITEMS;
    for (int it = it_lo + gw; it < it_hi; it += NGW) {
        int r = it;
        if (r < I_IN) { transpose_item(Win, D, 3 * D, ldin, (bf16*)(ws + WS_WIN), 0, scr, r, lane, gn, att ? 0 : 1); continue; } r -= I_IN;
        if (r < nF) {
            bf16* WT = (bf16*)(ws + WS_WIN);
#pragma unroll 4
            for (int e = lane; e < 64 * 16; e += 64) { const int kk = e >> 4, jj = e & 15; WT[(size_t)(3 * D + jj) * D + 64 * r + kk] = (bf16)f2bf(Win[(size_t)(64 * r + kk) * NIN_ATT + 3 * D + jj] * gn[64 * r + kk]); }
            continue; } r -= nF;
        if (r < I_O) { transpose_item(Wout, D, D, D, (bf16*)(ws + WS_WOUT), 0, scr, r, lane); continue; } r -= I_O;
        if (r < I_UP) { transpose_item(Wup, D, FF, FF, (bf16*)(ws + WS_WUP), 0, scr, r, lane, gn + 2 * D); continue; } r -= I_UP;
        if (r < I_DN) { transpose_item(Wdn, FF, D, D, (bf16*)(ws + WS_WDN), 0, scr, r, lane); continue; } r -= I_DN;
        if (r < I_G) { transpose_item(Wg, D, D, D, (bf16*)(ws + WS_WG + (li & 1) * WS_WALT), 0, scr, r, lane, gn + 4 * D); continue; } r -= I_G;
        transpose_item(Wp, PLE, D, D, (bf16*)(ws + WS_WP + (li & 1) * WS_WALT), 0, scr, r, lane);
    }
}
__device__ __forceinline__ void p0_rows(const float* xsrc, bf16* XBp, float* rs, int gw, int NGW, int lane_) {
    const int lane = opq_v(lane_);
    for (int m = 2 * gw; m < M; m += 2 * NGW) {
        f32x4 v[2][4]; float sq[2];
#pragma unroll
        for (int r = 0; r < 2; ++r) { const GAS f32x4* xr = (const GAS f32x4*)(xsrc + (size_t)(m + r) * D) + lane;
#pragma unroll
            for (int j = 0; j < 4; ++j) v[r][j] = xr[64 * j]; }
#pragma unroll
        for (int r = 0; r < 2; ++r) { sq[r] = 0.f;
#pragma unroll
            for (int j = 0; j < 4; ++j) sq[r] += (v[r][j].x * v[r][j].x + v[r][j].y * v[r][j].y) + (v[r][j].z * v[r][j].z + v[r][j].w * v[r][j].w); }
#pragma unroll
        for (int o = 1; o < 64; o <<= 1) { sq[0] += shflx_f(sq[0], o, lane); sq[1] += shflx_f(sq[1], o, lane); }
#pragma unroll
        for (int r = 0; r < 2; ++r) { if (lane == 0) rs[m + r] = 1.f / sqrtf(sq[r] * (1.f / D) + RMS_EPS);
            GAS unsigned long long* o8 = (GAS unsigned long long*)(XBp + (size_t)(m + r) * D) + lane;
#pragma unroll
            for (int j = 0; j < 4; ++j) o8[64 * j] = (unsigned long long)pk2(v[r][j].x, v[r][j].y) | ((unsigned long long)pk2(v[r][j].z, v[r][j].w) << 32); }
    }
}
__device__ __forceinline__ void p_phase(const float* psrc, bf16* pdst, int gw, int NGW, int lane_) {
    const int lane = opq_v(lane_);
    for (int m = 8 * gw; m < M; m += 8 * NGW) {
        f32x4 q[8];
#pragma unroll
        for (int r = 0; r < 8; ++r) q[r] = ((const GAS f32x4*)(psrc + (size_t)(m + r) * PLE))[lane];
#pragma unroll
        for (int r = 0; r < 8; ++r) ((GAS unsigned long long*)(pdst + (size_t)(m + r) * PLE))[lane] = (unsigned long long)pk2(q[r].x, q[r].y) | ((unsigned long long)pk2(q[r].z, q[r].w) << 32);
    }
}
__device__ __forceinline__ void bf8_to_f32(const v4u w, float (&f)[8]) {
    f[0] = __uint_as_float(w.x << 16); f[1] = __uint_as_float(w.x & 0xffff0000u); f[2] = __uint_as_float(w.y << 16); f[3] = __uint_as_float(w.y & 0xffff0000u);
    f[4] = __uint_as_float(w.z << 16); f[5] = __uint_as_float(w.z & 0xffff0000u); f[6] = __uint_as_float(w.w << 16); f[7] = __uint_as_float(w.w & 0xffff0000u);
}
__device__ __forceinline__ void conv_phase(const bf16* Bq, const bf16* Z, bf16* Yo, const float* cw, int gt_, int NGT) {
    const int gt = opq_v(gt_);
    constexpr int NITEMS = (M / 32) * (D / 8);
    for (int it = gt; it < NITEMS; it += NGT) {
        const int cgp = it & 127, rc = it >> 7, col = cgp * 8, t0 = rc * 32;
        float w0[8], w1[8], w2[8];
#pragma unroll
        for (int i = 0; i < 8; ++i) { w0[i] = cw[col + i]; w1[i] = cw[D + col + i]; w2[i] = cw[2 * D + col + i]; }
        float z1[8], z2[8];
        if ((t0 & (SEQ - 1)) == 0) {
#pragma unroll
            for (int i = 0; i < 8; ++i) { z1[i] = 0.f; z2[i] = 0.f; }
        } else {
            bf8_to_f32(*(const GAS v4u*)(Z + (size_t)(t0 - 1) * D + col), z1); bf8_to_f32(*(const GAS v4u*)(Z + (size_t)(t0 - 2) * D + col), z2);
        }
#pragma unroll 4
        for (int r = 0; r < 32; ++r) {
            const size_t off = (size_t)(t0 + r) * D + col;
            float z[8], bg[8], y[8];
            bf8_to_f32(*(const GAS v4u*)(Z + off), z); bf8_to_f32(*(const GAS v4u*)(Bq + off), bg);
#pragma unroll
            for (int i = 0; i < 8; ++i) { y[i] = bg[i] * (w0[i] * z2[i] + w1[i] * z1[i] + w2[i] * z[i]); z2[i] = z1[i]; z1[i] = z[i]; }
            v4u o; o.x = pk2(y[0], y[1]); o.y = pk2(y[2], y[3]); o.z = pk2(y[4], y[5]); o.w = pk2(y[6], y[7]);
            *(GAS v4u*)(Yo + off) = o;
        }
    }
}
__device__ __forceinline__ void logit_phase(const bf16* XNp, const bf16* Wf, const float* rs, float* flog, int gw, int NGW, int lane_) {
    typedef short bf16x8v __attribute__((ext_vector_type(8)));
    const int lane = opq_v(lane_), fr = lane & 15, fq = lane >> 4;
    for (int blk = gw; blk < M / 16; blk += NGW) {
        const bf16* ap = XNp + (size_t)(blk * 16 + fr) * D + 8 * fq; const bf16* bp = Wf + (size_t)fr * D + 8 * fq;
        f32x4 acc = {0.f, 0.f, 0.f, 0.f};
#pragma unroll 8
        for (int kk = 0; kk < D / 32; ++kk) { const bf16x8v w = *(const GAS bf16x8v*)(bp + 32 * kk), a = *(const GAS bf16x8v*)(ap + 32 * kk); acc = __builtin_amdgcn_mfma_f32_16x16x32_bf16(w, a, acc, 0, 0, 0); }
        acc = acc * rs[blk * 16 + fr];
        { const int row = blk * 16 + fr; float* fo = flog + ((size_t)((row >> 14) * 16 + 4 * fq) << 14) + (row & (SEQ - 1));
#pragma unroll
          for (int i = 0; i < 4; ++i) fo[(size_t)i << 14] = acc[i]; }
    }
}
__device__ __forceinline__ void gate_phase(const float* flog, const float* bfv, float* c2, unsigned* qkmax, const bf16* Q, const bf16* Kb, LAS unsigned char* lds, int G, int tid_, int wave, int lane_) {
    const int tid = opq_v(tid_), lane = opq_v(lane_);
    if (blockIdx.x < 32) {
        const int bh = blockIdx.x, b = bh >> 4, h = bh & 15; const float bias = bfv[h];
        const GAS f32x4* fp = (const GAS f32x4*)(flog + (size_t)bh * SEQ + 32 * tid);
        f32x4 zin[8];
#pragma unroll
        for (int k = 0; k < 8; ++k) zin[k] = fp[k];
        float v[32]; float run = 0.f;
#pragma unroll
        for (int k = 0; k < 32; ++k) { const float z = zin[k >> 2][k & 3] + bias; const float ls = fminf(z, 0.f) - __logf(1.f + __expf(-fabsf(z)));   run += ls; v[k] = run; }
        float incl = run;
#pragma unroll
        for (int o = 1; o < 64; o <<= 1) { const float y = __int_as_float(__builtin_amdgcn_ds_bpermute(((lane - o) & 63) << 2, __float_as_int(incl))); if (lane >= o) incl += y; }
        LAS float* wt = (LAS float*)lds;
        if (lane == 63) wt[wave] = incl;
        __syncthreads();
        float base = 0.f;
        for (int w = 0; w < wave; ++w) base += wt[w];
        const float excl = base + incl - run;
        GAS f32x4* dst = (GAS f32x4*)(c2 + (size_t)bh * SEQ + 32 * tid);
#pragma unroll
        for (int k = 0; k < 8; ++k) dst[k] = (f32x4){(excl + v[4 * k]) * LOG2E, (excl + v[4 * k + 1]) * LOG2E, (excl + v[4 * k + 2]) * LOG2E, (excl + v[4 * k + 3]) * LOG2E};
        __syncthreads();
    } else if (qkmax) {
        LAS unsigned* lm = (LAS unsigned*)lds;
        if (tid < 64) lm[tid] = 0u;
        __syncthreads();
        const int gw = (blockIdx.x - 32) * NWAVES + wave, NGW = (G - 32) * NWAVES;
#pragma unroll
        for (int b = 0; b < 2; ++b) {
            float mq[2] = {0.f, 0.f}, mk[2] = {0.f, 0.f};
            for (int r = 2 * gw; r < SEQ; r += 2 * NGW) {
                const size_t off0 = ((size_t)b * SEQ + r) * D + lane * 8;
                v4u qv[4], kv[4];
#pragma unroll
                for (int j = 0; j < 4; ++j) { qv[j] = *(const GAS v4u*)(Q + off0 + 512 * j); kv[j] = *(const GAS v4u*)(Kb + off0 + 512 * j); }
#pragma unroll
                for (int jj = 0; jj < 4; ++jj) { const int j = jj & 1;
                    float q[8], k[8]; bf8_to_f32(qv[jj], q); bf8_to_f32(kv[jj], k);
                    float sq = 0.f, sk = 0.f;
#pragma unroll
                    for (int i = 0; i < 8; ++i) { sq += q[i] * q[i]; sk += k[i] * k[i]; }
                    sq += shflx_f(sq, 1, lane); sk += shflx_f(sk, 1, lane); sq += shflx_f(sq, 2, lane); sk += shflx_f(sk, 2, lane); sq += shflx_f(sq, 4, lane); sk += shflx_f(sk, 4, lane);
                    mq[j] = fmaxf(mq[j], sq); mk[j] = fmaxf(mk[j], sk);
                }
            }
            if ((lane & 7) == 0) {
#pragma unroll
                for (int j = 0; j < 2; ++j) { const int hh = 8 * j + (lane >> 3); atomicMax((unsigned*)&lm[(b * 16 + hh) * 2], __float_as_uint(mq[j])); atomicMax((unsigned*)&lm[(b * 16 + hh) * 2 + 1], __float_as_uint(mk[j])); }
            }
        }
        __syncthreads();
        if (tid < 64) __hip_atomic_fetch_max(qkmax + tid, lm[tid], __ATOMIC_RELAXED, __HIP_MEMORY_SCOPE_AGENT);
        __syncthreads();
    }
}
#define RLX_AGENT __ATOMIC_RELAXED, __HIP_MEMORY_SCOPE_AGENT
constexpr int CW_BAR = 4096;
#define XB_TMO      128
#define XB_XCNT(j)  (256  + 64 * (j))
#define XB_XSUB(j)  (1280 + 64 * (j))
#define XB_XGEN(j)  (2304 + 64 * (j))
#define XB_TOP      3328
#define XB_TOPGEN   3392
#define XCD_BAR_WORDS 3456
#define XB_SPIN_CAP (1u << 18)

__device__ __forceinline__ unsigned xb_ld(unsigned* p)              { return __hip_atomic_load(p, __ATOMIC_RELAXED, __HIP_MEMORY_SCOPE_AGENT); }
__device__ __forceinline__ unsigned xb_add(unsigned* p, unsigned v) { return __hip_atomic_fetch_add(p, v, __ATOMIC_RELAXED, __HIP_MEMORY_SCOPE_AGENT); }
__device__ __forceinline__ unsigned xb_xcc_id() { return (unsigned)__builtin_amdgcn_s_getreg((3 << 11) | 20) & 0xFu; }
#define XB_SPIN(cond, bar) do { unsigned _sp = 0; while (cond) { __builtin_amdgcn_s_sleep(1); \
    if ((++_sp & 255u) == 0u) { if (xb_ld(&(bar)[XB_TMO])) break; if (_sp > XB_SPIN_CAP) { atomicAdd(&(bar)[XB_TMO], 1u); break; } } } } while (0)

struct XcdBarrier {
    unsigned* bar; unsigned x;
    volatile LAS unsigned* st;
};

__device__ __forceinline__ XcdBarrier xcd_barrier_post(unsigned* bar, volatile LAS unsigned* st) {
    XcdBarrier b; b.bar = bar; b.x = xb_xcc_id(); b.st = st;
    if (threadIdx.x == 0) (void)xb_add(&bar[XB_XCNT(b.x)], 1u);
    return b;
}
__device__ __forceinline__ void xcd_barrier_complete(unsigned* bar, unsigned x, unsigned& nloc, unsigned& nx) {
    const unsigned G = gridDim.x * gridDim.y * gridDim.z;
    unsigned sum, cnt, mine, sp = 0u;
    for (;;) {
        sum = 0u; cnt = 0u; mine = 0u;
#pragma unroll
        for (unsigned j = 0; j < 16; ++j) { const unsigned c = xb_ld(&bar[XB_XCNT(j)]); sum += c; cnt += (c > 0u) ? 1u : 0u; mine = (j == x) ? c : mine; }
        if (sum == G) break;
        __builtin_amdgcn_s_sleep(1);
        if ((++sp & 255u) == 0u) { if (xb_ld(&bar[XB_TMO])) break; if (sp > XB_SPIN_CAP) { atomicAdd(&bar[XB_TMO], 1u); break; } }
    }
    nloc = mine > 0u ? mine : 1u; nx = cnt > 0u ? cnt : 1u;
}

__device__ __forceinline__ void xcd_barrier(const XcdBarrier& b) {
    asm volatile("s_waitcnt vmcnt(0)" ::: "memory");
    __syncthreads();
    if (threadIdx.x == 0) {
        unsigned* bar = b.bar;
        __builtin_amdgcn_s_waitcnt(0);
        unsigned nloc = b.st[0], nx = b.st[1];
        if (nloc == 0u) { xcd_barrier_complete(bar, b.x, nloc, nx); b.st[0] = nloc; b.st[1] = nx; }
        __builtin_amdgcn_fence(__ATOMIC_RELEASE, "agent");
        asm volatile("s_waitcnt vmcnt(0)" ::: "memory");
        const unsigned old = xb_add(&bar[XB_XSUB(b.x)], 1u);
        const unsigned gen = old / nloc;
        if (old + 1u == (gen + 1u) * nloc) {
            __builtin_amdgcn_fence(__ATOMIC_RELEASE, "agent");
            asm volatile("s_waitcnt vmcnt(0)" ::: "memory");
            const unsigned og = xb_add(&bar[XB_TOP], 1u);
            const unsigned tg = og / nx;
            if (og + 1u == (tg + 1u) * nx) xb_add(&bar[XB_TOPGEN], 1u);
            else XB_SPIN(xb_ld(&bar[XB_TOPGEN]) == tg, bar);
            __builtin_amdgcn_fence(__ATOMIC_ACQUIRE, "agent");
            xb_add(&bar[XB_XGEN(b.x)], 1u);
            asm volatile("s_waitcnt vmcnt(0)" ::: "memory");
        } else {
            XB_SPIN(xb_ld(&bar[XB_XGEN(b.x)]) == gen, bar);
            __builtin_amdgcn_fence(__ATOMIC_ACQUIRE, "agent");
            asm volatile("s_waitcnt vmcnt(0)" ::: "memory");
        }
    }
    __syncthreads();
}

__global__ void __launch_bounds__(NWAVES * 64, 2) trunk_fwd(Args args) {
    extern __shared__ __attribute__((aligned(16))) unsigned char lds[];
    cg::grid_group grid = cg::this_grid();
    LAS unsigned char* L = (LAS unsigned char*)lds;
#define tid (opq_v((int)threadIdx.x))
#define lane (opq_v((int)threadIdx.x) & 63)
#define wave (__builtin_amdgcn_readfirstlane(opq_v((int)threadIdx.x) >> 6))
#define G (opq_s((int)gridDim.x))
#define bx (opq_s((int)blockIdx.x))
#define vcu (((int)gridDim.x % 8 == 0) ? (bx % 8) * ((int)gridDim.x / 8) + bx / 8 : bx)
#define gw (vcu * NWAVES + wave)
#define NGW (G * NWAVES)
    PTab PT = (PTab)(L + RING_BYTES);
    if (threadIdx.x == 0) {
#pragma unroll
        for (int i = 0; i < 13; ++i) PT[i] = (unsigned long long)args.in[i];
        PT[13] = (unsigned long long)args.out; PT[14] = (unsigned long long)args.ws;
    }
    __syncthreads();
    volatile LAS unsigned* xb_st = (volatile LAS unsigned*)(L + RING_BYTES + 256);
    if (threadIdx.x == 0) { xb_st[0] = 0u; xb_st[1] = 0u; }
    __syncthreads();
    (void)xcd_barrier_post((unsigned*)(ptab_ws(PT) + WS_CTL) + CW_BAR, xb_st);
#define GRID_SYNC() do { XcdBarrier b_; b_.bar = (unsigned*)(ptab_ws(PT) + WS_CTL) + CW_BAR; b_.x = xb_xcc_id(); b_.st = (volatile LAS unsigned*)(L + RING_BYTES + 256); xcd_barrier(b_); } while (0)
#define WSB(T, off) ((T*)(ptab_ws(PT) + (off)))

    convert_layer(PT, 0, L, gw, NGW, wave, lane, 1);
    p0_rows(ptab_in(PT, 0), WSB(bf16, WS_XB), WSB(float, WS_RS), gw, NGW, lane);
    GRID_SYNC();
    if (gridDim.y == 0xFFFFu) grid.sync();

#pragma unroll 1
    for (int li = 0; li < DEPTH; ++li) {
        const int j = li >> 1;
        if ((li & 1) == 0) {
            { pg8::Gemm gm{WSB(bf16, WS_XB), WSB(bf16, WS_WIN), M, 3 * D, D}; pg8::StaticOrder S; S.init(M, 3 * D, G, bx);
              pg8::EpiBf16<0> E{WSB(bf16, WS_QO), D, D, (size_t)(WS_K - WS_QO) / 2, attn_body::C2, nullptr, WSB(float, WS_RS), WSB(unsigned, WS_CTL) + CW_QKMAX + j * 128};
              pg8::gemm_phase<pg8::EpiBf16<0>, pg8::StaticOrder, true, true>(L + RING_OFF, gm, S, E); }
            logit_phase(WSB(bf16, WS_XB), WSB(bf16, WS_WIN) + (size_t)3 * D * D, WSB(float, WS_RS), WSB(float, WS_FLOG), gw, NGW, lane);
            if (li == 0) convert_layer(PT, 0, L, gw, NGW, wave, lane, 2);
            GRID_SYNC();
            if (bx >= 32) {
                p_phase(ptab_in(PT, 1) + (size_t)li * M * PLE, WSB(bf16, WS_PB), (bx - 32) * NWAVES + wave, (G - 32) * NWAVES, lane);
                p_phase(ptab_in(PT, 1) + (size_t)(li + 1) * M * PLE, WSB(bf16, WS_PB2), (bx - 32) * NWAVES + wave, (G - 32) * NWAVES, lane); }
            gate_phase(WSB(float, WS_FLOG), ptab_in(PT, 4) + j * H, WSB(float, WS_C2), nullptr, WSB(bf16, WS_QO), WSB(bf16, WS_K), L, G, tid, wave, lane);
            GRID_SYNC();
            volatile LAS int* wq_ = (volatile LAS int*)(L + RING_BYTES + 512);
            for (;;) {
                if (wave == 0 && lane == 0) *wq_ = (int)__hip_atomic_fetch_add(WSB(unsigned, WS_CTL) + CW_ATTQ + j * 64, 1u, __ATOMIC_RELAXED, __HIP_MEMORY_SCOPE_AGENT);
                __syncthreads();
                const int u = __builtin_amdgcn_readfirstlane(*wq_);
                __syncthreads();
                if (u >= BATCH * H * (SEQ / 256)) break;
                const int bh = u >> 6, qb = u & 63;
                unsigned* qkmax = WSB(unsigned, WS_CTL) + CW_QKMAX + j * 128 + bh * 4;
                const float qm = __uint_as_float(__hip_atomic_load(qkmax + 0, __ATOMIC_RELAXED, __HIP_MEMORY_SCOPE_AGENT)) + __uint_as_float(__hip_atomic_load(qkmax + 1, __ATOMIC_RELAXED, __HIP_MEMORY_SCOPE_AGENT));
                const float km = __uint_as_float(__hip_atomic_load(qkmax + 2, __ATOMIC_RELAXED, __HIP_MEMORY_SCOPE_AGENT)) + __uint_as_float(__hip_atomic_load(qkmax + 3, __ATOMIC_RELAXED, __HIP_MEMORY_SCOPE_AGENT));
                const float bnd = sqrtf(qm * km) * 1.02f + 1.0f;
                attn_body::fox_unit(bh >> 4, bh & 15, qb, (const attn_body::bf16*)WSB(bf16, WS_QO), (const attn_body::bf16*)WSB(bf16, WS_K), (const attn_body::bf16*)WSB(bf16, WS_V), (attn_body::bf16*)WSB(bf16, WS_QO), WSB(float, WS_C2) + (size_t)bh * SEQ, bnd, (char*)lds + RING_OFF);
            }
            GRID_SYNC();
        } else {
            { pg8::Gemm gm{WSB(bf16, WS_XB), WSB(bf16, WS_WIN), M, 3 * D, D}; pg8::StaticOrder S; S.init(M, 3 * D, G, bx);
              pg8::EpiBf16<4> E{WSB(bf16, WS_QO), D, D, (size_t)(WS_K - WS_QO) / 2, 1.f, nullptr, WSB(float, WS_RS), nullptr};
              pg8::gemm_phase<pg8::EpiBf16<4>, pg8::StaticOrder, true, true>(L + RING_OFF, gm, S, E); }
            GRID_SYNC();
            conv_phase(WSB(bf16, WS_QO), WSB(bf16, WS_K), WSB(bf16, WS_QO), ptab_in(PT, 7) + (size_t)j * 3 * D, vcu * NWAVES * 64 + tid, G * NWAVES * 64);
            GRID_SYNC();
        }
#define FUSED_GEMM(Aoff, Woff, KK, MUL, GA, IDX) do { \
            pg8::Gemm gm{WSB(bf16, Aoff), WSB(bf16, Woff), M, D, KK}; pg8::StaticOrder S; S.init(M, D, G, bx); \
            const unsigned want_ = 32u * (unsigned)(li * 3 + (IDX) + 1); unsigned* ctl_ = WSB(unsigned, WS_CTL); \
            pg8::PanelRms s1_{WSB(unsigned, WS_X1), ctl_ + CW_SEAM, ctl_ + CW_TMO, want_, RMS_EPS, nullptr}, s2_{WSB(unsigned, WS_X2), ctl_ + CW_SEAM + SEAM_BANK, ctl_ + CW_TMO, want_, RMS_EPS, WSB(float, WS_RS)}; \
            const bool first_ = (li == 0 && (IDX) == 0), last_ = (li + 1 == DEPTH && (IDX) == 2); \
            pg8::EpiRms E{first_ ? (const void*)ptab_in(PT, 0) : (const void*)WSB(bf16, WS_XB), last_ ? (void*)ptab_out(PT) : (void*)WSB(bf16, WS_XB), MUL, GA, D, s1_, s2_, first_ ? 1 : 0, last_ ? 1 : 0, last_ ? 0 : 1}; \
            _Pragma("unroll 1") for (int rd_ = 0; rd_ < 2; ++rd_) { pg8::RoundOrder R{S, rd_}; pg8::gemm_phase<pg8::EpiRms, pg8::RoundOrder, false, true>(L + RING_OFF, gm, R, E); } } while (0)
        { const float* g = ptab_in(PT, 2) + (size_t)li * 6 * D;
          FUSED_GEMM(WS_QO, WS_WOUT, D, (const bf16*)nullptr, g + D, 0); }
        GRID_SYNC();
        { pg8::Gemm gm{WSB(bf16, WS_XB), WSB(bf16, WS_WUP), M, FF, D}; pg8::StaticOrder S; S.init(M, FF, G, bx);
          pg8::EpiBf16<2> E{WSB(bf16, WS_H), FF, 0, 0, 1.f, nullptr, WSB(float, WS_RS), nullptr};
          pg8::gemm_phase<pg8::EpiBf16<2>, pg8::StaticOrder, true, true>(L + RING_OFF, gm, S, E); }
        GRID_SYNC();
        { const float* g = ptab_in(PT, 2) + (size_t)li * 6 * D;
          FUSED_GEMM(WS_H, WS_WDN, FF, (const bf16*)nullptr, g + 3 * D, 1); }
        GRID_SYNC();
        { pg8::Gemm gm{WSB(bf16, WS_XB), WSB(bf16, WS_WG + (li & 1) * WS_WALT), M, D, D}; pg8::StaticOrder S; S.init(M, D, G, bx);
          pg8::EpiBf16<3> E{WSB(bf16, WS_Y), D, 0, 0, 1.f, nullptr, WSB(float, WS_RS), nullptr};
          pg8::gemm_phase<pg8::EpiBf16<3>, pg8::StaticOrder, true, true>(L + RING_OFF, gm, S, E); }
        { const float* g = ptab_in(PT, 2) + (size_t)li * 6 * D;
          FUSED_GEMM(((li & 1) ? WS_PB2 : WS_PB), WS_WP + (li & 1) * WS_WALT, PLE, (const bf16*)WSB(bf16, WS_Y), g + 5 * D, 2); }
        if (li + 1 < DEPTH) { convert_layer(PT, li + 1, L, gw, NGW, wave, lane); GRID_SYNC(); }
    }
#undef tid
#undef lane
#undef wave
#undef G
#undef bx
#undef vcu
#undef gw
#undef NGW
}

extern "C" void kernel_launch(void* const* d_in, const int* in_sizes, int n_in, void* d_out, int out_size, void* d_ws, size_t ws_size, hipStream_t stream) {
    static int grid = 0;
    if (grid == 0) {
        if (n_in != 13 || in_sizes[0] != M * D || out_size != M * D || ws_size < WS_END) { fprintf(stderr, "kernel_launch: unexpected shapes (n_in %d, in0 %d, out %d, ws %zu)\n", n_in, n_in > 0 ? in_sizes[0] : -1, out_size, ws_size); grid = -1; return; }
        int dev = 0, cus = 0, per_cu = 0;
        if (hipGetDevice(&dev) != hipSuccess || hipDeviceGetAttribute(&cus, hipDeviceAttributeMultiprocessorCount, dev) != hipSuccess) { grid = -1; return; }
        if (hipFuncSetAttribute((const void*)trunk_fwd, hipFuncAttributeMaxDynamicSharedMemorySize, LDS_BYTES) != hipSuccess) { fprintf(stderr, "kernel_launch: hipFuncSetAttribute failed\n"); grid = -1; return; }
        if (hipOccupancyMaxActiveBlocksPerMultiprocessor(&per_cu, (const void*)trunk_fwd, NWAVES * 64, LDS_BYTES) != hipSuccess || per_cu < 1) { fprintf(stderr, "kernel_launch: occupancy query says %d\n", per_cu); per_cu = 1; }
        (void)hipGetLastError();
        grid = cus * per_cu;
    }
    if (grid < 0) return;
    (void)hipMemsetAsync((char*)d_ws + WS_CTL, 0, CTL_ZERO_BYTES, stream);
    Args a{};
    for (int i = 0; i < 13; ++i) a.in[i] = (const float*)d_in[i];
    a.out = (float*)d_out; a.ws = (unsigned char*)d_ws;
    void* kargs[] = {&a};
    hipError_t e = hipLaunchCooperativeKernel((const void*)trunk_fwd, dim3(grid), dim3(NWAVES * 64), kargs, LDS_BYTES, stream);
    if (e != hipSuccess) fprintf(stderr, "cooperative launch failed: %s (grid %d)\n", hipGetErrorString(e), grid);
}
```

```cpp
#include <hip/hip_runtime.h>
#include <hip/hip_cooperative_groups.h>
#include <cstdio>
#include <cstdint>
namespace cg = cooperative_groups;
__device__ __forceinline__ int opq_v(int v) { asm volatile("" : "+v"(v)); return v; }
__device__ __forceinline__ int opq_s(int v) { asm volatile("" : "+s"(v)); return v; }
__device__ __forceinline__ float shflx_f(float v, int mask, int lane) { return __int_as_float(__builtin_amdgcn_ds_bpermute((lane ^ mask) << 2, __float_as_int(v))); }
__device__ __forceinline__ int shflx_i(int v, int mask, int lane) { return __builtin_amdgcn_ds_bpermute((lane ^ mask) << 2, v); }
__device__ __forceinline__ float sum_rows4(float v) {
    auto a = __builtin_amdgcn_permlane16_swap(__float_as_uint(v), __float_as_uint(v), false, false); v = __uint_as_float(a[0]) + __uint_as_float(a[1]);
    auto b = __builtin_amdgcn_permlane32_swap(__float_as_uint(v), __float_as_uint(v), false, false); return __uint_as_float(b[0]) + __uint_as_float(b[1]);
}
namespace pg8 {
#define PG8_LAS __attribute__((address_space(3)))
typedef unsigned short bf16_t;
typedef short bf16x8 __attribute__((ext_vector_type(8)));
typedef float f32x4 __attribute__((ext_vector_type(4)));
typedef unsigned u32x4 __attribute__((ext_vector_type(4)));
constexpr int BM = 256, BK = 64, HALF = 128, HTB = HALF * BK * 2  , STAGE_BYTES = 8 * HTB, NXCD = 8, WGM = 8;

__host__ __device__ __forceinline__ int lds_byte(int r, int c) { const int st = (r >> 4) * 2 + (c >> 5), rr = r & 15, cc = c & 31, ob = rr * 64 + cc * 2; return st * 1024 + (ob ^ (((ob >> 9) & 1) << 5)); }
__host__ __device__ __forceinline__ void stage_rc(int b, int& R, int& C) { const int st = b / 1024, sb = b % 1024, swz = sb ^ (((sb >> 9) & 1) << 5); R = (st >> 1) * 16 + swz / 64; C = (st & 1) * 32 + (swz % 64) / 2; }
__host__ __device__ __forceinline__ int perm32(int rho) { const int n = rho >> 4, i = rho & 15; return 8 * (i >> 2) + 4 * n + (i & 3); }

struct Unit { int pm, pn; };
struct Gemm { const bf16_t* A; const bf16_t* Bt; int M, N, K; };

struct StaticOrder {
    int nM, nN, nwg, G, c;
    __host__ __device__ void init(int M, int N, int G_, int c_) { nM = M / BM; nN = N / BM; nwg = nM * nN; G = G_; c = c_; }
    __host__ __device__ bool next(int i, Unit& u) const {
        const long L = (long)i * G + c; if (L >= nwg) return false;
        int wgid = (int)L; { const int q = nwg / NXCD, r = nwg % NXCD, xcd = wgid % NXCD, off = wgid / NXCD; wgid = (xcd < r ? xcd * (q + 1) : r * (q + 1) + (xcd - r) * q) + off; }
        const int nig = WGM * nN, gid = wgid / nig, fm = gid * WGM, gsz = (nM - fm) < WGM ? (nM - fm) : WGM;
        u.pm = fm + ((wgid % nig) % gsz); u.pn = (wgid % nig) / gsz; return true;
    }
    __device__ __forceinline__ void a_ready(const Unit&) const {}
    __device__ __forceinline__ void done(const Unit&) const {}
};

__device__ __forceinline__ unsigned cvt_pk_bf16(float lo, float hi) { unsigned r; asm volatile("v_cvt_pk_bf16_f32 %0, %1, %2" : "=v"(r) : "v"(lo), "v"(hi)); return r; }
typedef float f32x2 __attribute__((ext_vector_type(2)));
typedef float f32x2 __attribute__((ext_vector_type(2)));
template <int ACT  > struct EpiBf16 {
    static constexpr bool PERM = true, AFTER_DRAIN = false, ADJ = true;
    bf16_t* O; int ldc; int split_cols; size_t split_stride; float scale0; float* flog; const float* rs; unsigned* qkm;
    __device__ __forceinline__ void operator()(const f32x4 (&acc)[2][2][4][2], const Unit& u, int wr, int wc, int fr, int fq) const {
        const int row0 = u.pm * BM + wr * 64 + fr; int colt = u.pn * BM; bf16_t* base = O;
        float sc = 1.f; int t = 0;
        if (split_cols) { t = colt / split_cols; base += (size_t)t * split_stride; colt -= t * split_cols; if (t == 0) sc = scale0; }
        if (t == 3) {
            if (wc == 0 && fq < 2) {
#pragma unroll
                for (int ai = 0; ai < 2; ++ai)
#pragma unroll
                    for (int m = 0; m < 4; ++m) { float* rp = flog + (size_t)(row0 + ai * HALF + m * 16) * 16 + 8 * fq; *(f32x4*)rp = acc[ai][0][m][0]; *(f32x4*)(rp + 4) = acc[ai][0][m][1]; }
            }
            return;
        }
        const int col0 = colt + wc * 64 + 8 * fq; const int lane_ = fq * 16 + fr;
        const bool trk = ACT == 0 && qkm != nullptr && t < 2; float cm0 = 0.f, cm1 = 0.f;
        if (ACT == 4 && t >= 1) {
            bf16_t* zb = O + split_stride + (size_t)row0 * ldc + (u.pn - 4) * 128 + wc * 32 + fq * 8;
#pragma unroll
            for (int ai = 0; ai < 2; ++ai)
#pragma unroll
                for (int m = 0; m < 4; ++m) { const float r2 = rs[row0 + ai * HALF + m * 16]; const float rr = r2 * r2;
                    const f32x4 z0 = acc[ai][0][m][0] * acc[ai][0][m][1] * rr, z1 = acc[ai][1][m][0] * acc[ai][1][m][1] * rr;
                    u32x4 w; w.x = cvt_pk_bf16(z0[0], z0[1]); w.y = cvt_pk_bf16(z0[2], z0[3]); w.z = cvt_pk_bf16(z1[0], z1[1]); w.w = cvt_pk_bf16(z1[2], z1[3]);
                    *(u32x4*)(zb + (size_t)(ai * HALF + m * 16) * ldc) = w; }
            return;
        }
        float rsv[2][4];
#pragma unroll
        for (int ai = 0; ai < 2; ++ai)
#pragma unroll
            for (int m = 0; m < 4; ++m) rsv[ai][m] = rs[row0 + ai * HALF + m * 16];
#pragma unroll
        for (int ai = 0; ai < 2; ++ai)
#pragma unroll
            for (int m = 0; m < 4; ++m) { bf16_t* rowp = base + (size_t)(row0 + ai * HALF + m * 16) * ldc + col0;
#pragma unroll
                for (int bj = 0; bj < 2; ++bj) { f32x4 v0 = acc[ai][bj][m][0] * rsv[ai][m], v1 = acc[ai][bj][m][1] * rsv[ai][m];
                    if (ACT == 3) {
#pragma unroll
                        for (int i = 0; i < 4; ++i) { v0[i] = 1.f / (1.f + __expf(-v0[i])); v1[i] = 1.f / (1.f + __expf(-v1[i])); } }
                    if (ACT == 2) {
#pragma unroll
                        for (int i = 0; i < 4; ++i) { const float a = fmaxf(v0[i], 0.f), b = fmaxf(v1[i], 0.f); v0[i] = a * a; v1[i] = b * b; } }
                    v0 = v0 * sc; v1 = v1 * sc; u32x4 w; w.x = cvt_pk_bf16(v0[0], v0[1]); w.y = cvt_pk_bf16(v0[2], v0[3]); w.z = cvt_pk_bf16(v1[0], v1[1]); w.w = cvt_pk_bf16(v1[2], v1[3]);
                    *(u32x4*)(rowp + bj * 32) = w;
                    if (trk) { float q = ((v0[0] * v0[0] + v0[1] * v0[1]) + (v0[2] * v0[2] + v0[3] * v0[3])) + ((v1[0] * v1[0] + v1[1] * v1[1]) + (v1[2] * v1[2] + v1[3] * v1[3]));
                        q = sum_rows4(q);
                        if (bj == 0) cm0 = fmaxf(cm0, q); else cm1 = fmaxf(cm1, q); } } }
        if (trk) {
#pragma unroll
            for (int o = 1; o < 16; o <<= 1) { cm0 = fmaxf(cm0, shflx_f(cm0, o, lane_)); cm1 = fmaxf(cm1, shflx_f(cm1, o, lane_)); }
            if (lane_ == 0) { const int b = (u.pm * BM) >> 14, hd = (colt >> 6) + wc;
                __hip_atomic_fetch_max(qkm + ((b * 16 + hd) * 2 + t) * 2 + 0, __float_as_uint(cm0), __ATOMIC_RELAXED, __HIP_MEMORY_SCOPE_AGENT);
                __hip_atomic_fetch_max(qkm + ((b * 16 + hd) * 2 + t) * 2 + 1, __float_as_uint(cm1), __ATOMIC_RELAXED, __HIP_MEMORY_SCOPE_AGENT); }
        }
    }
};
struct PanelRms {
    unsigned* xbuf;
    unsigned* cnt;
    unsigned* tmo;
    unsigned want; float eps; float* rsout;
    __device__ __forceinline__ void run(const f32x4 (&v)[2][2][4][2], const Unit& u, int wr, int wc, int fr, int fq, PG8_LAS unsigned char* lds, int wid, int lane) const {
        PG8_LAS float* P = (PG8_LAS float*)lds;
        PG8_LAS float* S = (PG8_LAS float*)(lds + 8192);
#pragma unroll
        for (int ai = 0; ai < 2; ++ai)
#pragma unroll
            for (int m = 0; m < 4; ++m) {
                float q = 0.f;
#pragma unroll
                for (int bj = 0; bj < 2; ++bj)
#pragma unroll
                    for (int n = 0; n < 2; ++n) { const f32x4 x = v[ai][bj][m][n]; q += (x[0] * x[0] + x[1] * x[1]) + (x[2] * x[2] + x[3] * x[3]); }
                q = sum_rows4(q);
                if (fq == 0) P[(ai * HALF + wr * 64 + m * 16 + fr) * 4 + wc] = q;
            }
        asm volatile("s_waitcnt lgkmcnt(0)" ::: "memory"); __builtin_amdgcn_s_barrier(); asm volatile("" ::: "memory");
        const int row = wid * 32 + (lane & 31);
        if (lane < 32) {
            const f32x4 p = *(const PG8_LAS f32x4*)(P + row * 4);
            __hip_atomic_store(xbuf + ((size_t)(u.pm * BM + row) * 4 + u.pn), __float_as_uint((p[0] + p[1]) + (p[2] + p[3])), __ATOMIC_RELAXED, __HIP_MEMORY_SCOPE_AGENT);
        }
        asm volatile("s_waitcnt vmcnt(0)" ::: "memory");
        if (lane == 0) __hip_atomic_fetch_add(cnt + 64 * u.pm, 1u, __ATOMIC_RELAXED, __HIP_MEMORY_SCOPE_AGENT);
        if (wid == 0) {
            for (int sp = 0;; ++sp) {
                if ((unsigned)__builtin_amdgcn_readfirstlane(__hip_atomic_load(cnt + 64 * u.pm, __ATOMIC_RELAXED, __HIP_MEMORY_SCOPE_AGENT)) >= want) break;
                if (sp > 65536) { if (lane == 0) __hip_atomic_store(tmo, 1u, __ATOMIC_RELAXED, __HIP_MEMORY_SCOPE_AGENT); break; }
                __builtin_amdgcn_s_sleep(2);
            }
            __builtin_amdgcn_fence(__ATOMIC_ACQUIRE, "agent");
        }
        asm volatile("s_waitcnt vmcnt(0) lgkmcnt(0)" ::: "memory"); __builtin_amdgcn_s_barrier(); asm volatile("" ::: "memory");
        if (lane < 32) {
            const unsigned* slot = xbuf + (size_t)(u.pm * BM + row) * 4; float q = 0.f;
#pragma unroll
            for (int t = 0; t < 4; ++t) q += __uint_as_float(__hip_atomic_load(slot + t, __ATOMIC_RELAXED, __HIP_MEMORY_SCOPE_AGENT));
            const float rstd_ = 1.0f / sqrtf(q * (1.0f / 1024.0f) + eps); S[row] = rstd_;
            if (rsout && u.pn == 0) rsout[u.pm * BM + row] = rstd_;
        }
        asm volatile("s_waitcnt lgkmcnt(0)" ::: "memory"); __builtin_amdgcn_s_barrier(); asm volatile("" ::: "memory");
    }
};
struct EpiRms {
    static constexpr bool PERM = true, AFTER_DRAIN = true, ADJ = false;
    const void* base; void* out; const bf16_t* mul; const float* gA; int ldc; PanelRms st1, st2; int base_f32, out_f32, need_rs;
    __device__ __forceinline__ void fused(f32x4 (&acc)[2][2][4][2], const Unit& u, int wr, int wc, int fr, int fq, PG8_LAS unsigned char* lds, int wid, int lane) const {
        typedef unsigned u32x2v __attribute__((ext_vector_type(2)));
        const PG8_LAS float* S = (const PG8_LAS float*)(lds + 8192);
        const int col0 = u.pn * BM + wc * 32 + 8 * fq;
        const unsigned b0 = (unsigned)((u.pm * BM + wr * 64 + fr) * ldc + col0) * 4u;
#define RMS_OFF(ai, m, bj, n) (b0 + (unsigned)(((ai) * HALF + (m) * 16) * ldc + (bj) * HALF + (n) * 4) * 4u)
#define RMS_UNPK(PK_, lo, hi) do { lo = (f32x4){__uint_as_float((PK_)[0] << 16), __uint_as_float((PK_)[0] & 0xffff0000u), __uint_as_float((PK_)[1] << 16), __uint_as_float((PK_)[1] & 0xffff0000u)}; \
                                   hi = (f32x4){__uint_as_float((PK_)[2] << 16), __uint_as_float((PK_)[2] & 0xffff0000u), __uint_as_float((PK_)[3] << 16), __uint_as_float((PK_)[3] & 0xffff0000u)}; } while (0)
#define RMS_LOADX(ai, m, bj, lo, hi) do { if (base_f32) { lo = *(const f32x4*)((const char*)base + RMS_OFF(ai, m, bj, 0)); hi = *(const f32x4*)((const char*)base + RMS_OFF(ai, m, bj, 1)); } \
                                          else { const u32x4 w_ = *(const u32x4*)((const char*)base + (RMS_OFF(ai, m, bj, 0) >> 1)); RMS_UNPK(w_, lo, hi); } } while (0)
#define RMS_STOREX(ai, m, bj, lo, hi) do { if (out_f32) { *(f32x4*)((char*)out + RMS_OFF(ai, m, bj, 0)) = lo; *(f32x4*)((char*)out + RMS_OFF(ai, m, bj, 1)) = hi; } \
                                           else { u32x4 w_; w_.x = cvt_pk_bf16(lo[0], lo[1]); w_.y = cvt_pk_bf16(lo[2], lo[3]); w_.z = cvt_pk_bf16(hi[0], hi[1]); w_.w = cvt_pk_bf16(hi[2], hi[3]); \
                                                  *(u32x4*)((char*)out + (RMS_OFF(ai, m, bj, 0) >> 1)) = w_; } } while (0)
        if (mul) {
#pragma unroll
            for (int ai = 0; ai < 2; ++ai)
#pragma unroll
                for (int m = 0; m < 4; ++m) {
#pragma unroll
                    for (int bj = 0; bj < 2; ++bj) { const u32x4 w = *(const u32x4*)((const char*)mul + (RMS_OFF(ai, m, bj, 0) >> 1)); f32x4 lo, hi; RMS_UNPK(w, lo, hi);
                        acc[ai][bj][m][0] = acc[ai][bj][m][0] * lo; acc[ai][bj][m][1] = acc[ai][bj][m][1] * hi; }
                    asm volatile("" : "+v"(acc[ai][0][m][0]), "+v"(acc[ai][0][m][1]), "+v"(acc[ai][1][m][0]), "+v"(acc[ai][1][m][1]));
                    if (m & 1) asm volatile("" ::: "memory"); }
        }
        f32x4 pre[2][2][2];
#pragma unroll
        for (int m = 0; m < 2; ++m)
#pragma unroll
            for (int bj = 0; bj < 2; ++bj) RMS_LOADX(0, m, bj, pre[m][bj][0], pre[m][bj][1]);
        f32x4 gpre[2][2];
#pragma unroll
        for (int bj = 0; bj < 2; ++bj)
#pragma unroll
            for (int n = 0; n < 2; ++n) gpre[bj][n] = *(const f32x4*)(gA + col0 + bj * HALF + n * 4);
        st1.run(acc, u, wr, wc, fr, fq, lds, wid, lane);
#pragma unroll
        for (int bj = 0; bj < 2; ++bj)
#pragma unroll
            for (int n = 0; n < 2; ++n) { const f32x4 g = gpre[bj][n];
#pragma unroll
                for (int ai = 0; ai < 2; ++ai)
#pragma unroll
                    for (int m = 0; m < 4; ++m) acc[ai][bj][m][n] = acc[ai][bj][m][n] * g; }
#pragma unroll
        for (int ai = 0; ai < 2; ++ai)
#pragma unroll
            for (int m = 0; m < 4; ++m) { const float sr = S[ai * HALF + wr * 64 + m * 16 + fr];
#pragma unroll
                for (int bj = 0; bj < 2; ++bj) { f32x4 lo, hi;
                    if (ai == 0 && m < 2) { lo = pre[m & 1][bj][0]; hi = pre[m & 1][bj][1]; } else RMS_LOADX(ai, m, bj, lo, hi);
                    acc[ai][bj][m][0] = lo + acc[ai][bj][m][0] * sr; acc[ai][bj][m][1] = hi + acc[ai][bj][m][1] * sr;
                    RMS_STOREX(ai, m, bj, acc[ai][bj][m][0], acc[ai][bj][m][1]); }
                asm volatile("" : "+v"(acc[ai][0][m][0]), "+v"(acc[ai][0][m][1]), "+v"(acc[ai][1][m][0]), "+v"(acc[ai][1][m][1]));
                asm volatile("" ::: "memory"); }
        if (need_rs) st2.run(acc, u, wr, wc, fr, fq, lds, wid, lane);
        asm volatile("s_waitcnt lgkmcnt(0)" ::: "memory"); __builtin_amdgcn_s_barrier(); asm volatile("" ::: "memory");
#undef RMS_OFF
#undef RMS_UNPK
#undef RMS_LOADX
#undef RMS_STOREX
    }
};
struct RoundOrder {
    StaticOrder b; int round;
    __device__ __forceinline__ bool next(int i, Unit& u) const { return i == 0 && b.next(round, u); }
    __device__ __forceinline__ void a_ready(const Unit&) const {}
    __device__ __forceinline__ void done(const Unit&) const {}
};

template <class Epi, class Sched, bool ALIGN_EPI = false, bool SP2 = false>
__device__ __forceinline__ void gemm_phase(PG8_LAS unsigned char* lds, const Gemm g, const Sched& S, const Epi& E) {
    const int tid = opq_v((int)threadIdx.x), wid = __builtin_amdgcn_readfirstlane(tid >> 6), lane = tid & 63, wr = wid >> 2, wc = wid & 3, fr = lane & 15, fq = lane >> 4;
    const int K = g.K, nt = K / BK;
    unsigned voffA[2], voffB[2];
#pragma unroll
    for (int i = 0; i < 2; ++i) { int R, C; stage_rc(tid * 16 + i * 8192, R, C); const int Rb = Epi::ADJ ? (64 * (R >> 5) + perm32(R & 31)) : Epi::PERM ? ((R & ~31) + perm32(R & 31)) : R;
        voffA[i] = (unsigned)(R * K + C) * 2u; voffB[i] = (unsigned)(Rb * K + C) * 2u; }
    const size_t kstep = (size_t)(BK * 2);
    const size_t hstep = (size_t)HALF * K * 2;
    const size_t tstep = 2 * hstep;
    const size_t bhstep = Epi::ADJ ? (size_t)32 * K * 2 : hstep;
    const unsigned ldsw = (unsigned)wid * 1024u;
    const int aoff = lds_byte(wr * 64 + fr, fq * 8), boff = lds_byte(wc * 32 + fr, fq * 8);
#define PG8_SA(b, h) (((b) * 2 + (h)) * HTB)
#define PG8_SB(b, h) ((4 + (b) * 2 + (h)) * HTB)
#define PG8_STAGE(bufoff, gbase, voff) do { _Pragma("unroll") for (int _i = 0; _i < 2; ++_i) \
        __builtin_amdgcn_global_load_lds((const unsigned*)((const char*)(gbase) + (voff)[_i]), (PG8_LAS unsigned*)(lds + (bufoff) + ldsw + _i * 8192), 16, 0, 0); } while (0)
#define PG8_LDA(dst, b, h) do { _Pragma("unroll") for (int m = 0; m < 4; ++m) _Pragma("unroll") for (int k = 0; k < 2; ++k) dst[m][k] = *(const PG8_LAS bf16x8*)(lds + PG8_SA(b, h) + aoff + m * 2048 + k * 1024); } while (0)
#define PG8_LDB(dst, b, h) do { _Pragma("unroll") for (int n = 0; n < 2; ++n) _Pragma("unroll") for (int k = 0; k < 2; ++k) dst[n][k] = *(const PG8_LAS bf16x8*)(lds + PG8_SB(b, h) + boff + n * 2048 + k * 1024); } while (0)
#define PG8_MMA(ai, bj, At, Bt) do { __builtin_amdgcn_s_setprio(1); _Pragma("unroll") for (int m = 0; m < 4; ++m) _Pragma("unroll") for (int n = 0; n < 2; ++n) _Pragma("unroll") for (int k = 0; k < 2; ++k) \
        acc[ai][bj][m][n] = __builtin_amdgcn_mfma_f32_16x16x32_bf16(Bt[n][k], At[m][k], acc[ai][bj][m][n], 0, 0, 0); __builtin_amdgcn_s_setprio(0); } while (0)
#define PG8_WAIT_V(n) asm volatile("s_waitcnt vmcnt(" #n ")" ::: "memory")
#define PG8_WAIT_L(n) asm volatile("s_waitcnt lgkmcnt(" #n ")" ::: "memory")
#define PG8_BAR __builtin_amdgcn_s_barrier()
#define PG8_SCHED __builtin_amdgcn_sched_barrier(0)
    Unit cur, nxt; int ui = 0;
    if (!S.next(0, cur)) return;
    f32x4 acc[2][2][4][2];
#pragma unroll
    for (int a = 0; a < 2; ++a)
#pragma unroll
        for (int b = 0; b < 2; ++b)
#pragma unroll
            for (int m = 0; m < 4; ++m)
#pragma unroll
                for (int n = 0; n < 2; ++n) acc[a][b][m][n] = (f32x4){0.f, 0.f, 0.f, 0.f};
    bf16x8 At[4][2], B0[2][2], B1[2][2];
    const char* cA = (const char*)g.A + (size_t)cur.pm * tstep; const char* cB = (const char*)g.Bt + (size_t)cur.pn * tstep;
    S.a_ready(cur);
    if constexpr (SP2) {
        PG8_STAGE(PG8_SB(0, 0), cB, voffB); PG8_STAGE(PG8_SB(0, 1), cB + bhstep, voffB); PG8_STAGE(PG8_SA(0, 0), cA, voffA); PG8_STAGE(PG8_SA(0, 1), cA + hstep, voffA);
        if (wr == 1) PG8_BAR;
        PG8_WAIT_V(2); PG8_BAR;
        PG8_STAGE(PG8_SB(1, 0), cB + kstep, voffB); PG8_STAGE(PG8_SA(1, 0), cA + kstep, voffA); PG8_STAGE(PG8_SB(1, 1), cB + bhstep + kstep, voffB);
        PG8_WAIT_V(6); PG8_BAR;
    } else {
        PG8_STAGE(PG8_SB(0, 0), cB, voffB); PG8_STAGE(PG8_SA(0, 0), cA, voffA); PG8_STAGE(PG8_SB(0, 1), cB + bhstep, voffB); PG8_STAGE(PG8_SA(0, 1), cA + hstep, voffA);
        if (wr == 1) PG8_BAR;
        PG8_WAIT_V(4); PG8_BAR;
        PG8_STAGE(PG8_SB(1, 0), cB + kstep, voffB); PG8_STAGE(PG8_SA(1, 0), cA + kstep, voffA); PG8_STAGE(PG8_SB(1, 1), cB + bhstep + kstep, voffB);
        PG8_WAIT_V(6); PG8_BAR;
    }
    for (;;) {
        const bool has_next = S.next(ui + 1, nxt);
        const char* nA = has_next ? (const char*)g.A + (size_t)nxt.pm * tstep : cA; const char* nB = has_next ? (const char*)g.Bt + (size_t)nxt.pn * tstep : cB;
        for (int t = 0; t < nt; t += 2) {
            const bool last = (t == nt - 2);
            const char* a1 = cA + (size_t)(t + 1) * kstep;
            const char* a2 = last ? nA : cA + (size_t)(t + 2) * kstep; const char* b2 = last ? nB : cB + (size_t)(t + 2) * kstep;
            const char* a3 = a2 + kstep; const char* b3 = b2 + kstep;
            if (last && has_next) S.a_ready(nxt);
            if constexpr (SP2) {
            PG8_LDB(B0, 0, 0); PG8_LDB(B1, 0, 1); PG8_SCHED; PG8_LDA(At, 0, 0); PG8_STAGE(PG8_SA(1, 1), a1 + hstep, voffA);
            PG8_WAIT_V(8); PG8_WAIT_L(0); PG8_BAR; PG8_MMA(0, 0, At, B0); PG8_MMA(0, 1, At, B1); PG8_BAR; PG8_SCHED;
            PG8_LDA(At, 0, 1); PG8_STAGE(PG8_SB(0, 0), b2, voffB); PG8_STAGE(PG8_SB(0, 1), b2 + bhstep, voffB); PG8_STAGE(PG8_SA(0, 0), a2, voffA);
            PG8_WAIT_V(8); PG8_WAIT_L(0); PG8_BAR; PG8_MMA(1, 0, At, B0); PG8_MMA(1, 1, At, B1); PG8_BAR; PG8_SCHED;
            PG8_LDB(B0, 1, 0); PG8_LDB(B1, 1, 1); PG8_SCHED; PG8_LDA(At, 1, 0); PG8_STAGE(PG8_SA(0, 1), a2 + hstep, voffA);
            PG8_WAIT_V(8); PG8_WAIT_L(0); PG8_BAR; PG8_MMA(0, 0, At, B0); PG8_MMA(0, 1, At, B1); PG8_BAR; PG8_SCHED;
            PG8_LDA(At, 1, 1); PG8_STAGE(PG8_SB(1, 0), b3, voffB); PG8_STAGE(PG8_SB(1, 1), b3 + bhstep, voffB); PG8_STAGE(PG8_SA(1, 0), a3, voffA);
            PG8_WAIT_V(8); PG8_WAIT_L(0); PG8_BAR; PG8_MMA(1, 0, At, B0); PG8_MMA(1, 1, At, B1); PG8_BAR; PG8_SCHED;
            } else {
            PG8_LDB(B0, 0, 0); PG8_SCHED; PG8_LDA(At, 0, 0); PG8_STAGE(PG8_SA(1, 1), a1 + hstep, voffA);
            PG8_WAIT_L(8); PG8_BAR; PG8_WAIT_L(0); PG8_MMA(0, 0, At, B0); PG8_BAR; PG8_SCHED;
            PG8_LDB(B1, 0, 1); PG8_STAGE(PG8_SB(0, 0), b2, voffB);
            PG8_BAR; PG8_WAIT_L(0); PG8_MMA(0, 1, At, B1); PG8_BAR;
            PG8_LDA(At, 0, 1); PG8_STAGE(PG8_SA(0, 0), a2, voffA);
            PG8_BAR; PG8_WAIT_L(0); PG8_MMA(1, 0, At, B0); PG8_BAR; PG8_SCHED;
            PG8_STAGE(PG8_SB(0, 1), b2 + bhstep, voffB);
            PG8_WAIT_V(6); PG8_BAR; PG8_MMA(1, 1, At, B1); PG8_BAR;
            PG8_LDB(B0, 1, 0); PG8_SCHED; PG8_LDA(At, 1, 0); PG8_STAGE(PG8_SA(0, 1), a2 + hstep, voffA);
            PG8_WAIT_L(8); PG8_BAR; PG8_WAIT_L(0); PG8_MMA(0, 0, At, B0); PG8_BAR; PG8_SCHED;
            PG8_LDB(B1, 1, 1); PG8_STAGE(PG8_SB(1, 0), b3, voffB);
            PG8_BAR; PG8_WAIT_L(0); PG8_MMA(0, 1, At, B1); PG8_BAR;
            PG8_LDA(At, 1, 1); PG8_STAGE(PG8_SA(1, 0), a3, voffA);
            PG8_BAR; PG8_WAIT_L(0); PG8_MMA(1, 0, At, B0); PG8_BAR; PG8_SCHED;
            PG8_STAGE(PG8_SB(1, 1), b3 + bhstep, voffB);
            PG8_WAIT_V(6); PG8_BAR; PG8_MMA(1, 1, At, B1); PG8_BAR;
            }
        }
        if constexpr (ALIGN_EPI) { if (wr == 0) PG8_BAR; }
        if constexpr (!Epi::AFTER_DRAIN) { E(acc, cur, wr, wc, fr, fq); S.done(cur); }
        if (!has_next) break;
#pragma unroll
        for (int a = 0; a < 2; ++a)
#pragma unroll
            for (int b = 0; b < 2; ++b)
#pragma unroll
                for (int m = 0; m < 4; ++m)
#pragma unroll
                    for (int n = 0; n < 2; ++n) acc[a][b][m][n] = (f32x4){0.f, 0.f, 0.f, 0.f};
        cur = nxt; cA = nA; cB = nB; ++ui;
        if constexpr (ALIGN_EPI) { if (wr == 1) PG8_BAR; }
    }
    PG8_WAIT_V(0);
    if constexpr (!ALIGN_EPI) { if (wr == 0) PG8_BAR; }
    PG8_BAR;
    if constexpr (Epi::AFTER_DRAIN) { E.fused(acc, cur, wr, wc, fr, fq, lds, wid, lane); S.done(cur); }
#undef PG8_SA
#undef PG8_SB
#undef PG8_STAGE
#undef PG8_LDA
#undef PG8_LDB
#undef PG8_MMA
#undef PG8_WAIT_V
#undef PG8_WAIT_L
#undef PG8_BAR
#undef PG8_SCHED
}
}
#include <hip/hip_bf16.h>
#include <cmath>
namespace attn_body {
using bf16=__hip_bfloat16;
using bf16x8=__attribute__((ext_vector_type(8)))short;
using s16x4=__attribute__((ext_vector_type(4)))short;
using f32x16=__attribute__((ext_vector_type(16)))float;
using u32x4=__attribute__((ext_vector_type(4)))unsigned;
constexpr int BATCH=2,NHEAD=16,SEQ=16384,D=64,DM=NHEAD*D;
constexpr int NW=8,QBLK=32,QB=QBLK*NW,KVBLK=64,NQB=SEQ/QB;
constexpr int ATTN_PITCH=DM, ATTN_UNIT_ROWS=QB;
__device__ __forceinline__ int crow(int r,int hi){return (r&3)+8*(r>>2)+4*hi;}
#define SBAR() __builtin_amdgcn_sched_barrier(0)
__device__ __forceinline__ void cmask(f32x16&p0,f32x16&p1,int jb,int qrel,int hi){
  const float NEG=__int_as_float(opq_s((int)0xff800000)); int kb=64*jb+4*hi;
  #pragma unroll
  for(int r=0;r<16;++r){int kv=kb+(r&3)+8*(r>>2); if(kv>qrel)p0[r]=NEG; if(kv+32>qrel)p1[r]=NEG;}
}

constexpr int NSLOT=3, SLOTB=8192;
constexpr int LDS_K=0, LDS_V=NSLOT*SLOTB, LDS_WS=2*NSLOT*SLOTB, LDS_CK=LDS_WS+NW*64*4, LDS_OST=LDS_CK, LDS_BYTES=LDS_CK+65536;
constexpr float C2=0.125f*1.4426950408889634f;
__device__ __forceinline__ void glds16(const void*gsrc,unsigned lds_dst){unsigned keep;
  asm volatile("s_mov_b32 %0, m0\n\ts_mov_b32 m0, %2\n\ts_nop 0\n\tglobal_load_lds_dwordx4 %1, off\n\ts_mov_b32 m0, %0":"=&s"(keep):"v"(gsrc),"s"(lds_dst):"memory");}
__device__ __forceinline__ float max3f(float a,float b,float c){float r;asm("v_max3_f32 %0, %1, %2, %3":"=v"(r):"v"(a),"v"(b),"v"(c));return r;}
__device__ __forceinline__ float max2f(float a,float b){float r;asm("v_max_f32_e32 %0, %1, %2":"=v"(r):"v"(a),"v"(b));return r;}
__device__ __forceinline__ float fadd_s(float a,float b){float r;asm("v_add_f32_e32 %0, %1, %2":"=v"(r):"v"(a),"v"(b));return r;}
__device__ __forceinline__ float fsub_s(float a,float b){float r;asm("v_sub_f32_e32 %0, %1, %2":"=v"(r):"v"(a),"v"(b));return r;}
typedef float f32x2_t __attribute__((ext_vector_type(2))); typedef __bf16 bf16x2_t __attribute__((ext_vector_type(2)));
__device__ __forceinline__ unsigned cvtpk_s(float lo,float hi){f32x2_t v={lo,hi};bf16x2_t b=__builtin_convertvector(v,bf16x2_t);return __builtin_bit_cast(unsigned,b);}
#define WAIT_BAR(N) asm volatile("s_waitcnt vmcnt(" #N ") lgkmcnt(0)\n\ts_barrier":::"memory")

__device__ __forceinline__ void qkt(f32x16&p0,f32x16&p1,const char*Kslot,const bf16x8*qr,const f32x16&negm,int r32,int hi){
  const char*kb=Kslot+hi*1024+r32*16;
  #pragma unroll
  for(int d0=0;d0<4;++d0){
    const bf16x8 b0=*reinterpret_cast<const bf16x8*>(kb+d0*2048);
    const bf16x8 b1=*reinterpret_cast<const bf16x8*>(kb+d0*2048+512);
    if(d0==0){p0=__builtin_amdgcn_mfma_f32_32x32x16_bf16(b0,qr[0],negm,0,0,0);p1=__builtin_amdgcn_mfma_f32_32x32x16_bf16(b1,qr[0],negm,0,0,0);}
    else{p0=__builtin_amdgcn_mfma_f32_32x32x16_bf16(b0,qr[d0],p0,0,0,0);p1=__builtin_amdgcn_mfma_f32_32x32x16_bf16(b1,qr[d0],p1,0,0,0);}}
}
typedef __attribute__((address_space(3))) const char* lds_cptr;
typedef short v4i16_t __attribute__((ext_vector_type(4)));
__device__ __forceinline__ void kload8(bf16x8*kf,lds_cptr kp){
  kf[0]=*(const __attribute__((address_space(3))) bf16x8*)(kp);      kf[1]=*(const __attribute__((address_space(3))) bf16x8*)(kp+512);
  kf[2]=*(const __attribute__((address_space(3))) bf16x8*)(kp+2048); kf[3]=*(const __attribute__((address_space(3))) bf16x8*)(kp+2560);
  kf[4]=*(const __attribute__((address_space(3))) bf16x8*)(kp+4096); kf[5]=*(const __attribute__((address_space(3))) bf16x8*)(kp+4608);
  kf[6]=*(const __attribute__((address_space(3))) bf16x8*)(kp+6144); kf[7]=*(const __attribute__((address_space(3))) bf16x8*)(kp+6656);
}
__device__ __forceinline__ void kload2(bf16x8*kf,lds_cptr kp,int j){ kf[2*j]=*(const __attribute__((address_space(3))) bf16x8*)(kp+j*2048); kf[2*j+1]=*(const __attribute__((address_space(3))) bf16x8*)(kp+j*2048+512); }
__device__ __forceinline__ s16x4 vtr(lds_cptr p){ return __builtin_bit_cast(s16x4,__builtin_amdgcn_ds_read_tr16_b64_v4i16((__attribute__((address_space(3))) v4i16_t*)p)); }
__device__ __forceinline__ float rowmax(const f32x16&p0,const f32x16&p1){
  float a=max3f(p0[0],p0[1],p1[0]),b=max3f(p0[2],p0[3],p1[1]);a=max3f(a,p1[2],p1[3]);
  #pragma unroll
  for(int r=4;r<16;r+=4){a=max3f(a,p0[r],p0[r+1]);b=max3f(b,p0[r+2],p0[r+3]);a=max3f(a,p1[r],p1[r+1]);b=max3f(b,p1[r+2],p1[r+3]);}
  const float m=max2f(a,b);
  auto rr=__builtin_amdgcn_permlane32_swap(__float_as_uint(m),__float_as_uint(m),false,false);
  return max2f(__uint_as_float(rr[0]),__uint_as_float(rr[1]));
}
__device__ __forceinline__ void pv(f32x16*o,int vb,bf16x8 pa0,bf16x8 pa1,bf16x8 pa2,bf16x8 pa3){
  #pragma unroll
  for(int d0=0;d0<2;++d0){s16x4 lo[4],hi[4];
    #pragma unroll
    for(int ks=0;ks<4;++ks){
      asm volatile("ds_read_b64_tr_b16 %0,%1 offset:%c2":"=&v"(lo[ks]):"v"(vb),"i"(d0*4096+ks*1024):"memory");
      asm volatile("ds_read_b64_tr_b16 %0,%1 offset:%c2":"=&v"(hi[ks]):"v"(vb),"i"(d0*4096+ks*1024+512):"memory");}
    asm volatile("s_waitcnt lgkmcnt(0)":::"memory");SBAR();
    #define PK(k) (bf16x8){lo[k][0],lo[k][1],lo[k][2],lo[k][3],hi[k][0],hi[k][1],hi[k][2],hi[k][3]}
    o[d0]=__builtin_amdgcn_mfma_f32_32x32x16_bf16(pa0,PK(0),o[d0],0,0,0);
    o[d0]=__builtin_amdgcn_mfma_f32_32x32x16_bf16(pa1,PK(1),o[d0],0,0,0);
    o[d0]=__builtin_amdgcn_mfma_f32_32x32x16_bf16(pa2,PK(2),o[d0],0,0,0);
    o[d0]=__builtin_amdgcn_mfma_f32_32x32x16_bf16(pa3,PK(3),o[d0],0,0,0);
    #undef PK
  }
}
constexpr float SKIP_T=40.f;
#ifndef ATTN_STORE16
#define ATTN_STORE16(p,v) (*(u32x4*)(p)=(v))
#endif
typedef float f32x4a __attribute__((ext_vector_type(4)));
__device__ __forceinline__ void fox_unit(int b,int h,int qb,const bf16*Q,const bf16*__restrict__ K,const bf16*__restrict__ V,bf16*O,const float*__restrict__ c2h,float bnd,char*shm){
  const int tid=opq_v((int)threadIdx.x),lane=tid&63,r32=lane&31,hi=lane>>5; const int wid=__builtin_amdgcn_readfirstlane(tid>>6);
  const long rowbase=(long)b*SEQ; const int q0=qb*QB;
  const bf16*Qw=Q+(rowbase+q0+wid*QBLK)*DM+h*D;
  const bf16*Kh=K+rowbase*DM+h*D,*Vh=V+rowbase*DM+h*D;
  const unsigned lds0=(unsigned)(uintptr_t)shm;
  float*wsf=(float*)(shm+LDS_WS)+wid*64;
  float*CK=(float*)(shm+LDS_CK);
  const bf16*ksrc=Kh+(long)lane*DM+wid*8;
  const bf16*vsrc=Vh+(long)(16*(wid&3)+(lane>>2))*DM+(wid>>2)*32+(lane&3)*8;
  const unsigned kdst=lds0+LDS_K+wid*1024, vdst=lds0+LDS_V+wid*1024;
  #define DMA_K(t,slot) glds16(ksrc+(long)(t)*KVBLK*DM,(unsigned)__builtin_amdgcn_readfirstlane(kdst+(slot)))
  #define DMA_V(t,slot) glds16(vsrc+(long)(t)*KVBLK*DM,(unsigned)__builtin_amdgcn_readfirstlane(vdst+(slot)))
  const int vb0=(int)(lds0+LDS_V)+((lane>>4)&1)*32+(lane&3)*8+(4*hi+((lane&15)>>2))*64;
  const char*Kbase=shm+LDS_K;
  const int NT=(q0+QB)/KVBLK;
  const float thr=c2h[q0]+2.f*bnd+SKIP_T;
  int tl=NT-4;
  for(int t=lane;t<NT-4;t+=64){ if(!(c2h[64*t+63]>thr)) tl=min(tl,t); }
  #pragma unroll
  for(int o_=32;o_>=1;o_>>=1) tl=min(tl,shflx_i(tl,o_,lane));
  tl=__builtin_amdgcn_readfirstlane(tl);
  const int n=NT-tl;
  DMA_K(NT-1,0);DMA_V(NT-1,0);
  for(int i=tid*4;i<64*n;i+=NW*64*4) *(f32x4a*)(CK+i)=*(const f32x4a*)(c2h+64*tl+i);
  bf16x8 qr[4];
  #pragma unroll
  for(int d0=0;d0<4;++d0)qr[d0]=*reinterpret_cast<const bf16x8*>(&Qw[(long)r32*DM+d0*16+hi*8]);
  const float cq=c2h[q0+wid*QBLK+r32];
  float mhat=-bnd,l_reg=0.f;f32x16 o[2];o[0]=f32x16{};o[1]=f32x16{};f32x16 negm;
  #pragma unroll
  for(int r=0;r<16;++r)negm[r]=cq-mhat;
  const int qrel=wid*QBLK+r32;
  int sl=0,sl_n=SLOTB;
  for(int it=0;it<n;++it){
    const int t=NT-1-it;
    if(it+1<n){ DMA_K(t-1,sl_n); DMA_V(t-1,sl_n); WAIT_BAR(2); } else { WAIT_BAR(0); }
    if(!(it<4 && 64*(3-it)>32*wid+31)){
    f32x16 p0,p1;
    qkt(p0,p1,Kbase+sl,qr,negm,r32,hi);
    { const float*ckt=CK+(t-tl)*64+4*hi;
      #pragma unroll
      for(int g=0;g<4;++g){ const f32x4a ca=*(const f32x4a*)(ckt+8*g), cb=*(const f32x4a*)(ckt+32+8*g);
        #pragma unroll
        for(int i=0;i<4;++i){ p0[4*g+i]-=ca[i]; p1[4*g+i]-=cb[i]; } } }
    if(it<4)cmask(p0,p1,3-it,qrel,hi);
    float rm;
    { float a=__builtin_fmaxf(p0[0],p1[0]);
      #pragma unroll
      for(int r=1;r<16;++r)a=__builtin_fmaxf(a,__builtin_fmaxf(p0[r],p1[r]));
      auto rr=__builtin_amdgcn_permlane32_swap(__float_as_uint(a),__float_as_uint(a),false,false);
      rm=__builtin_fmaxf(__uint_as_float(rr[0]),__uint_as_float(rr[1])); }
    const float mnew=__builtin_fmaxf(mhat,rm), dl=mnew-mhat;
    if(__any(dl>0.f)){
      const float f=__builtin_amdgcn_exp2f(-dl); l_reg*=f; if(hi==0)wsf[r32]=f;
      asm volatile("s_waitcnt lgkmcnt(0)":::"memory");
      #pragma unroll
      for(int d_=0;d_<2;++d_)
        #pragma unroll
        for(int r=0;r<16;++r)o[d_][r]*=wsf[crow(r,hi)];
      mhat=mnew;
      #pragma unroll
      for(int r=0;r<16;++r){negm[r]=cq-mhat;p0[r]-=dl;p1[r]-=dl;}
    }
    float sacc=0.f;
    #pragma unroll
    for(int r=0;r<16;++r){p0[r]=__builtin_amdgcn_exp2f(p0[r]);p1[r]=__builtin_amdgcn_exp2f(p1[r]);sacc+=p0[r]+p1[r];}
    l_reg+=sacc;
    { u32x4 pw0,pw1,pw2,pw3;
      #define PKW(P,B) cvtpk_s(P[B],P[B+1])
      pw0=(u32x4){PKW(p0,0),PKW(p0,2),PKW(p0,4),PKW(p0,6)};pw1=(u32x4){PKW(p0,8),PKW(p0,10),PKW(p0,12),PKW(p0,14)};pw2=(u32x4){PKW(p1,0),PKW(p1,2),PKW(p1,4),PKW(p1,6)};pw3=(u32x4){PKW(p1,8),PKW(p1,10),PKW(p1,12),PKW(p1,14)};
      #undef PKW
      SBAR(); pv(o,vb0+sl,__builtin_bit_cast(bf16x8,pw0),__builtin_bit_cast(bf16x8,pw1),__builtin_bit_cast(bf16x8,pw2),__builtin_bit_cast(bf16x8,pw3)); }
    }
    sl=sl_n; sl_n=(sl_n==(NSLOT-1)*SLOTB)?0:sl_n+SLOTB;
  }
  asm volatile("s_waitcnt lgkmcnt(0)\n\ts_barrier":::"memory");
  {auto rr=__builtin_amdgcn_permlane32_swap(__float_as_uint(l_reg),__float_as_uint(l_reg),false,false);l_reg=__uint_as_float(rr[0])+__uint_as_float(rr[1]);}
  if(hi==0)wsf[32+r32]=l_reg;asm volatile("s_waitcnt lgkmcnt(0)":::"memory");
  float rli[16];
  #pragma unroll
  for(int r=0;r<16;++r)rli[r]=__builtin_amdgcn_rcpf(wsf[32+crow(r,hi)]);
  bf16*Ow=O+(rowbase+q0+wid*QBLK)*DM+h*D;
  { bf16*stg=(bf16*)(shm+LDS_OST)+wid*2048;
    #pragma unroll
    for(int r=0;r<16;++r){const int orow=crow(r,hi);
      #pragma unroll
      for(int d0=0;d0<2;++d0)stg[orow*64+d0*32+r32]=__float2bfloat16(o[d0][r]*rli[r]);}
    asm volatile("s_waitcnt lgkmcnt(0)":::"memory");
    #pragma unroll
    for(int i=0;i<4;++i){const int row=i*8+(lane>>3),ch=lane&7; const u32x4 v=*(const u32x4*)(stg+row*64+ch*8); ATTN_STORE16(Ow+(long)row*DM+ch*8,v);} }
  asm volatile("s_waitcnt lgkmcnt(0)\n\ts_barrier":::"memory");
  #undef DMA_K
  #undef DMA_V
}
constexpr int ATTN_LDS_BYTES=LDS_BYTES;
#undef SBAR
#undef WAIT_BAR
}
constexpr int NWAVES = 8;
constexpr int BATCH = 2, SEQ = 16384, D = 1024, H = 16, HD = 64, FF = 4096, PLE = 256, DEPTH = 4;
constexpr int M = BATCH * SEQ;
constexpr int NIN_ATT = 3 * D + H;
constexpr float RMS_EPS = 1e-6f;
constexpr float LOG2E = 1.4426950408889634f;
constexpr size_t MiB = 1u << 20;
constexpr size_t WS_CTL = 0, CTL_ZERO_BYTES = 1 * MiB;
constexpr size_t WS_C2 = 1 * MiB, WS_FLOG = 3 * MiB;
constexpr size_t WS_X1 = 5 * MiB, WS_X2 = 6 * MiB, WS_RS = 7 * MiB;
constexpr size_t WS_WIN = 8 * MiB, WS_WOUT = 15 * MiB, WS_WUP = 17 * MiB, WS_WDN = 25 * MiB, WS_WG = 33 * MiB, WS_WP = 35 * MiB, WS_WALT = 3 * MiB;
constexpr size_t WS_PB = 40 * MiB, WS_PB2 = 56 * MiB  , WS_QO = 120 * MiB, WS_K = 184 * MiB, WS_V = 248 * MiB, WS_H = 120 * MiB, WS_Y = 376 * MiB  , WS_XB = 440 * MiB  , WS_END = 504 * MiB;
constexpr int CW_TMO = 0, CW_SEAM = 16384, SEAM_BANK = 128 * 64;
constexpr int CW_ATTQ = 2048;
constexpr int CW_QKMAX = 1024;
constexpr int RING_OFF = 0, RING_BYTES = 131072, LDS_BYTES = 147456;
static_assert(attn_body::ATTN_LDS_BYTES <= RING_BYTES, "attention LDS");

#define GAS __attribute__((address_space(1)))
#define LAS __attribute__((address_space(3)))
typedef unsigned short bf16;
typedef unsigned v4u __attribute__((ext_vector_type(4)));
typedef float f32x4 __attribute__((ext_vector_type(4)));
#define LDS_WAIT() asm volatile("s_waitcnt lgkmcnt(0)" ::: "memory")
__device__ __forceinline__ unsigned f2bf(float f) { unsigned u = __builtin_bit_cast(unsigned, f); return (u + 0x7fffu + ((u >> 16) & 1u)) >> 16; }
__device__ __forceinline__ unsigned pk2(float lo, float hi) { return f2bf(lo) | (f2bf(hi) << 16); }
__device__ __forceinline__ float wave_sum(float v) {
#pragma unroll
    for (int o = 1; o < 64; o <<= 1) v += __shfl_xor(v, o);
    return v;
}
__device__ __forceinline__ void transpose_item(const float* W, int K, int N, int ldn, bf16* WT, int row_off, LAS float* scr, int item, int lane, const float* g = nullptr, int cumode = 0) {
    const int nblk = N / 32, kb = item / nblk, nb = item % nblk, k0 = 64 * kb, n0 = 32 * nb;
    int srcc = n0 + 4 * (lane & 7);
    if (cumode && srcc >= 1024) { const int cu = srcc - 1024, col = cu & 255; srcc = (((col >> 2) & 1) ? 2048 : 1024) + (cu >> 8) * 128 + (col >> 6) * 32 + ((col >> 3) & 3) * 8 + ((col >> 5) & 1) * 4; }
    { f32x4 t[8];
#pragma unroll
      for (int i = 0; i < 8; ++i) t[i] = *(const GAS f32x4*)(W + (size_t)(k0 + 8 * i + (lane >> 3)) * ldn + srcc);
      if (g) {
#pragma unroll
        for (int i = 0; i < 8; ++i) t[i] = t[i] * g[k0 + 8 * i + (lane >> 3)]; }
#pragma unroll
      for (int i = 0; i < 8; ++i) { LAS float* d = scr + (8 * i + (lane >> 3)) * 33 + 4 * (lane & 7); d[0] = t[i].x; d[1] = t[i].y; d[2] = t[i].z; d[3] = t[i].w; } }
    LDS_WAIT(); asm volatile("" ::: "memory");
    const int c = lane & 7;
#pragma unroll
    for (int j = 0; j < 4; ++j) { const int n = (lane >> 3) + 8 * j; const LAS float* s = scr + (8 * c) * 33 + n;
        v4u o; o.x = pk2(s[0 * 33], s[1 * 33]); o.y = pk2(s[2 * 33], s[3 * 33]); o.z = pk2(s[4 * 33], s[5 * 33]); o.w = pk2(s[6 * 33], s[7 * 33]);
        *(GAS v4u*)(WT + (size_t)(row_off + n0 + n) * K + k0 + 8 * c) = o; }
    LDS_WAIT(); asm volatile("" ::: "memory");
}
struct Args { const float* in[13]; float* out; unsigned char* ws; };
typedef volatile LAS unsigned long long* PTab;
__device__ __forceinline__ unsigned long long ptab_raw(PTab PT, int i) { const unsigned a_ = (unsigned)opq_s((int)(unsigned)(size_t)PT + 8 * i);
    const unsigned long long v = *(volatile LAS unsigned long long*)a_; return ((unsigned long long)(unsigned)__builtin_amdgcn_readfirstlane((int)(unsigned)(v >> 32)) << 32) | (unsigned)__builtin_amdgcn_readfirstlane((int)(unsigned)v); }
__device__ __forceinline__ const float* ptab_in(PTab PT, int i) { return (const float*)(const GAS float*)ptab_raw(PT, i); }
__device__ __forceinline__ unsigned char* ptab_ws(PTab PT) { return (unsigned char*)(GAS unsigned char*)ptab_raw(PT, 14); }
__device__ __forceinline__ float* ptab_out(PTab PT) { return (float*)(GAS float*)ptab_raw(PT, 13); }
struct TDesc { const float* W; int K, N, ldn; bf16* WT; const float* g; int cumode; int item; };
__device__ __forceinline__ void ti_load(const TDesc& d, int lane, f32x4 (&t)[8]) {
    const int nblk = d.N / 32, kb = d.item / nblk, nb = d.item % nblk, k0 = 64 * kb, n0 = 32 * nb;
    int srcc = n0 + 4 * (lane & 7);
    if (d.cumode && srcc >= 1024) { const int cu = srcc - 1024, col = cu & 255; srcc = (((col >> 2) & 1) ? 2048 : 1024) + (cu >> 8) * 128 + (col >> 6) * 32 + ((col >> 3) & 3) * 8 + ((col >> 5) & 1) * 4; }
#pragma unroll
    for (int i = 0; i < 8; ++i) t[i] = *(const GAS f32x4*)(d.W + (size_t)(k0 + 8 * i + (lane >> 3)) * d.ldn + srcc);
    if (d.g) {
#pragma unroll
        for (int i = 0; i < 8; ++i) t[i] = t[i] * d.g[k0 + 8 * i + (lane >> 3)]; }
}
__device__ __forceinline__ void ti_finish(const TDesc& d, int lane, const f32x4 (&t)[8], LAS float* scr) {
    const int nblk = d.N / 32, kb = d.item / nblk, nb = d.item % nblk, k0 = 64 * kb, n0 = 32 * nb;
#pragma unroll
    for (int i = 0; i < 8; ++i) { LAS float* p = scr + (8 * i + (lane >> 3)) * 33 + 4 * (lane & 7); p[0] = t[i].x; p[1] = t[i].y; p[2] = t[i].z; p[3] = t[i].w; }
    LDS_WAIT(); asm volatile("" ::: "memory");
    const int c = lane & 7;
#pragma unroll
    for (int j = 0; j < 4; ++j) { const int n = (lane >> 3) + 8 * j; const LAS float* q = scr + (8 * c) * 33 + n;
        v4u o; o.x = pk2(q[0 * 33], q[1 * 33]); o.y = pk2(q[2 * 33], q[3 * 33]); o.z = pk2(q[4 * 33], q[5 * 33]); o.w = pk2(q[6 * 33], q[7 * 33]);
        *(GAS v4u*)(d.WT + (size_t)(n0 + n) * d.K + k0 + 8 * c) = o; }
    LDS_WAIT(); asm volatile("" ::: "memory");
}
__device__ __forceinline__ void convert_layer(PTab PT, int li, LAS unsigned char* lds, int gw, int NGW, int wave, int lane_, int part = 0) {
    const int lane = opq_v(lane_);
    LAS float* scr = (LAS float*)(lds + RING_OFF + wave * 16384);
    unsigned char* ws = ptab_ws(PT); const int j = li >> 1; const bool att = (li & 1) == 0;
    const float* Win = att ? ptab_in(PT, 3) + (size_t)j * D * NIN_ATT : ptab_in(PT, 6) + (size_t)j * D * 3 * D; const int ldin = att ? NIN_ATT : 3 * D;
    const float* Wout = att ? ptab_in(PT, 5) + (size_t)j * D * D : ptab_in(PT, 8) + (size_t)j * D * D;
    const float* Wup = ptab_in(PT, 9) + (size_t)li * D * FF; const float* Wdn = ptab_in(PT, 10) + (size_t)li * FF * D;
    const float* Wp = ptab_in(PT, 11) + (size_t)li * PLE * D; const float* Wg = ptab_in(PT, 12) + (size_t)li * D * D;
    const float* gn = ptab_in(PT, 2) + (size_t)li * 6 * D;
    constexpr int I_IN = (D / 64) * (3 * D / 32), I_O = (D / 64) * (D / 32), I_UP = (D / 64) * (FF / 32), I_DN = (FF / 64) * (D / 32), I_G = I_O, I_P = (PLE / 64) * (D / 32), I_F = D / 64;
    constexpr int NT_ITEMS = I_IN + I_O + I_UP + I_DN + I_G + I_P;
    if (att && part != 2) {
        for (int r = gw; r < I_F; r += NGW) { bf16* WT = (bf16*)(ws + WS_WIN);
#pragma unroll 4
            for (int e = lane; e < 64 * 16; e += 64) { const int kk = e >> 4, jj = e & 15; WT[(size_t)(3 * D + jj) * D + 64 * r + kk] = (bf16)f2bf(Win[(size_t)(64 * r + kk) * NIN_ATT + 3 * D + jj] * gn[64 * r + kk]); } }
    }
    const int it_lo = part == 2 ? I_IN : 0, it_hi = part == 1 ? I_IN : NT_ITEMS;
#define CL_DECODE(IT, DD) do { int r_ = (IT); \
        if (r_ < I_IN) { DD = TDesc{Win, D, 3 * D, ldin, (bf16*)(ws + WS_WIN), gn, att ? 0 : 1, r_}; break; } r_ -= I_IN; \
        if (r_ < I_O) { DD = TDesc{Wout, D, D, D, (bf16*)(ws + WS_WOUT), nullptr, 0, r_}; break; } r_ -= I_O; \
        if (r_ < I_UP) { DD = TDesc{Wup, D, FF, FF, (bf16*)(ws + WS_WUP), gn + 2 * D, 0, r_}; break; } r_ -= I_UP; \
        if (r_ < I_DN) { DD = TDesc{Wdn, FF, D, D, (bf16*)(ws + WS_WDN), nullptr, 0, r_}; break; } r_ -= I_DN; \
        if (r_ < I_G) { DD = TDesc{Wg, D, D, D, (bf16*)(ws + WS_WG + (li & 1) * WS_WALT), gn + 4 * D, 0, r_}; break; } r_ -= I_G; \
        DD = TDesc{Wp, PLE, D, D, (bf16*)(ws + WS_WP + (li & 1) * WS_WALT), nullptr, 0, r_}; } while (0)
    int it = it_lo + gw;
    if (it < it_hi) {
        TDesc d; f32x4 t[8]; CL_DECODE(it, d); ti_load(d, lane, t);
        for (;;) {
            const int nx = it + NGW; const bool more = nx < it_hi; TDesc d2 = d; f32x4 t2[8];
            if (more) { CL_DECODE(nx, d2); ti_load(d2, lane, t2); }
            ti_finish(d, lane, t, scr);
            if (!more) break;
            it = nx; d = d2;
#pragma unroll
            for (int i = 0; i < 8; ++i) t[i] = t2[i];
        }
    }
#undef CL_DECODE
}
__device__ __forceinline__ void p0_rows(const float* xsrc, bf16* XBp, float* rs, int gw, int NGW, int lane_) {
    const int lane = opq_v(lane_);
    for (int m = 2 * gw; m < M; m += 2 * NGW) {
        f32x4 v[2][4]; float sq[2];
#pragma unroll
        for (int r = 0; r < 2; ++r) { const GAS f32x4* xr = (const GAS f32x4*)(xsrc + (size_t)(m + r) * D) + lane;
#pragma unroll
            for (int j = 0; j < 4; ++j) v[r][j] = xr[64 * j]; }
#pragma unroll
        for (int r = 0; r < 2; ++r) { sq[r] = 0.f;
#pragma unroll
            for (int j = 0; j < 4; ++j) sq[r] += (v[r][j].x * v[r][j].x + v[r][j].y * v[r][j].y) + (v[r][j].z * v[r][j].z + v[r][j].w * v[r][j].w); }
#pragma unroll
        for (int o = 1; o < 64; o <<= 1) { sq[0] += shflx_f(sq[0], o, lane); sq[1] += shflx_f(sq[1], o, lane); }
#pragma unroll
        for (int r = 0; r < 2; ++r) { if (lane == 0) rs[m + r] = 1.f / sqrtf(sq[r] * (1.f / D) + RMS_EPS);
            GAS unsigned long long* o8 = (GAS unsigned long long*)(XBp + (size_t)(m + r) * D) + lane;
#pragma unroll
            for (int j = 0; j < 4; ++j) o8[64 * j] = (unsigned long long)pk2(v[r][j].x, v[r][j].y) | ((unsigned long long)pk2(v[r][j].z, v[r][j].w) << 32); }
    }
}
__device__ __forceinline__ void p_phase(const float* psrc, bf16* pdst, int gw, int NGW, int lane_) {
    const int lane = opq_v(lane_);
    for (int m = 8 * gw; m < M; m += 8 * NGW) {
        f32x4 q[8];
#pragma unroll
        for (int r = 0; r < 8; ++r) q[r] = ((const GAS f32x4*)(psrc + (size_t)(m + r) * PLE))[lane];
#pragma unroll
        for (int r = 0; r < 8; ++r) ((GAS unsigned long long*)(pdst + (size_t)(m + r) * PLE))[lane] = (unsigned long long)pk2(q[r].x, q[r].y) | ((unsigned long long)pk2(q[r].z, q[r].w) << 32);
    }
}
__device__ __forceinline__ void bf8_to_f32(const v4u w, float (&f)[8]) {
    f[0] = __uint_as_float(w.x << 16); f[1] = __uint_as_float(w.x & 0xffff0000u); f[2] = __uint_as_float(w.y << 16); f[3] = __uint_as_float(w.y & 0xffff0000u);
    f[4] = __uint_as_float(w.z << 16); f[5] = __uint_as_float(w.z & 0xffff0000u); f[6] = __uint_as_float(w.w << 16); f[7] = __uint_as_float(w.w & 0xffff0000u);
}
__device__ __forceinline__ void conv_phase(const bf16* Bq, const bf16* Z, bf16* Yo, const float* cw, int gt_, int NGT) {
    const int gt = opq_v(gt_);
    constexpr int NITEMS = (M / 32) * (D / 8);
    for (int it = gt; it < NITEMS; it += NGT) {
        const int cgp = it & 127, rc = it >> 7, col = cgp * 8, t0 = rc * 32;
        float w0[8], w1[8], w2[8];
#pragma unroll
        for (int i = 0; i < 8; ++i) { w0[i] = cw[col + i]; w1[i] = cw[D + col + i]; w2[i] = cw[2 * D + col + i]; }
        float z1[8], z2[8];
        if ((t0 & (SEQ - 1)) == 0) {
#pragma unroll
            for (int i = 0; i < 8; ++i) { z1[i] = 0.f; z2[i] = 0.f; }
        } else {
            bf8_to_f32(*(const GAS v4u*)(Z + (size_t)(t0 - 1) * D + col), z1); bf8_to_f32(*(const GAS v4u*)(Z + (size_t)(t0 - 2) * D + col), z2);
        }
#pragma unroll 4
        for (int r = 0; r < 32; ++r) {
            const size_t off = (size_t)(t0 + r) * D + col;
            float z[8], bg[8], y[8];
            bf8_to_f32(*(const GAS v4u*)(Z + off), z); bf8_to_f32(*(const GAS v4u*)(Bq + off), bg);
#pragma unroll
            for (int i = 0; i < 8; ++i) { y[i] = bg[i] * (w0[i] * z2[i] + w1[i] * z1[i] + w2[i] * z[i]); z2[i] = z1[i]; z1[i] = z[i]; }
            v4u o; o.x = pk2(y[0], y[1]); o.y = pk2(y[2], y[3]); o.z = pk2(y[4], y[5]); o.w = pk2(y[6], y[7]);
            *(GAS v4u*)(Yo + off) = o;
        }
    }
}
__device__ __forceinline__ void logit_phase(const bf16* XNp, const bf16* Wf, const float* rs, float* flog, int gw, int NGW, int lane_) {
    typedef short bf16x8v __attribute__((ext_vector_type(8)));
    const int lane = opq_v(lane_), fr = lane & 15, fq = lane >> 4;
    for (int blk = gw; blk < M / 16; blk += NGW) {
        const bf16* ap = XNp + (size_t)(blk * 16 + fr) * D + 8 * fq; const bf16* bp = Wf + (size_t)fr * D + 8 * fq;
        f32x4 acc = {0.f, 0.f, 0.f, 0.f};
#pragma unroll 8
        for (int kk = 0; kk < D / 32; ++kk) { const bf16x8v w = *(const GAS bf16x8v*)(bp + 32 * kk), a = *(const GAS bf16x8v*)(ap + 32 * kk); acc = __builtin_amdgcn_mfma_f32_16x16x32_bf16(w, a, acc, 0, 0, 0); }
        acc = acc * rs[blk * 16 + fr];
        { const int row = blk * 16 + fr; float* fo = flog + ((size_t)((row >> 14) * 16 + 4 * fq) << 14) + (row & (SEQ - 1));
#pragma unroll
          for (int i = 0; i < 4; ++i) fo[(size_t)i << 14] = acc[i]; }
    }
}
__device__ __forceinline__ void gate_phase(const float* flog, const float* bfv, float* c2, unsigned* qkmax, const bf16* Q, const bf16* Kb, LAS unsigned char* lds, int G, int tid_, int wave, int lane_) {
    const int tid = opq_v(tid_), lane = opq_v(lane_);
    if (blockIdx.x < 32) {
        const int bh = blockIdx.x, b = bh >> 4, h = bh & 15; const float bias = bfv[h];
        const GAS f32x4* fp = (const GAS f32x4*)(flog + (size_t)bh * SEQ + 32 * tid);
        f32x4 zin[8];
#pragma unroll
        for (int k = 0; k < 8; ++k) zin[k] = fp[k];
        float v[32]; float run = 0.f;
#pragma unroll
        for (int k = 0; k < 32; ++k) { const float z = zin[k >> 2][k & 3] + bias; const float ls = fminf(z, 0.f) - __logf(1.f + __expf(-fabsf(z)));   run += ls; v[k] = run; }
        float incl = run;
#pragma unroll
        for (int o = 1; o < 64; o <<= 1) { const float y = __int_as_float(__builtin_amdgcn_ds_bpermute(((lane - o) & 63) << 2, __float_as_int(incl))); if (lane >= o) incl += y; }
        LAS float* wt = (LAS float*)lds;
        if (lane == 63) wt[wave] = incl;
        __syncthreads();
        float base = 0.f;
        for (int w = 0; w < wave; ++w) base += wt[w];
        const float excl = base + incl - run;
        GAS f32x4* dst = (GAS f32x4*)(c2 + (size_t)bh * SEQ + 32 * tid);
#pragma unroll
        for (int k = 0; k < 8; ++k) dst[k] = (f32x4){(excl + v[4 * k]) * LOG2E, (excl + v[4 * k + 1]) * LOG2E, (excl + v[4 * k + 2]) * LOG2E, (excl + v[4 * k + 3]) * LOG2E};
        __syncthreads();
    } else if (qkmax) {
        LAS unsigned* lm = (LAS unsigned*)lds;
        if (tid < 64) lm[tid] = 0u;
        __syncthreads();
        const int gw = (blockIdx.x - 32) * NWAVES + wave, NGW = (G - 32) * NWAVES;
#pragma unroll
        for (int b = 0; b < 2; ++b) {
            float mq[2] = {0.f, 0.f}, mk[2] = {0.f, 0.f};
            for (int r = 2 * gw; r < SEQ; r += 2 * NGW) {
                const size_t off0 = ((size_t)b * SEQ + r) * D + lane * 8;
                v4u qv[4], kv[4];
#pragma unroll
                for (int j = 0; j < 4; ++j) { qv[j] = *(const GAS v4u*)(Q + off0 + 512 * j); kv[j] = *(const GAS v4u*)(Kb + off0 + 512 * j); }
#pragma unroll
                for (int jj = 0; jj < 4; ++jj) { const int j = jj & 1;
                    float q[8], k[8]; bf8_to_f32(qv[jj], q); bf8_to_f32(kv[jj], k);
                    float sq = 0.f, sk = 0.f;
#pragma unroll
                    for (int i = 0; i < 8; ++i) { sq += q[i] * q[i]; sk += k[i] * k[i]; }
                    sq += shflx_f(sq, 1, lane); sk += shflx_f(sk, 1, lane); sq += shflx_f(sq, 2, lane); sk += shflx_f(sk, 2, lane); sq += shflx_f(sq, 4, lane); sk += shflx_f(sk, 4, lane);
                    mq[j] = fmaxf(mq[j], sq); mk[j] = fmaxf(mk[j], sk);
                }
            }
            if ((lane & 7) == 0) {
#pragma unroll
                for (int j = 0; j < 2; ++j) { const int hh = 8 * j + (lane >> 3); atomicMax((unsigned*)&lm[(b * 16 + hh) * 2], __float_as_uint(mq[j])); atomicMax((unsigned*)&lm[(b * 16 + hh) * 2 + 1], __float_as_uint(mk[j])); }
            }
        }
        __syncthreads();
        if (tid < 64) __hip_atomic_fetch_max(qkmax + tid, lm[tid], __ATOMIC_RELAXED, __HIP_MEMORY_SCOPE_AGENT);
        __syncthreads();
    }
}
#define RLX_AGENT __ATOMIC_RELAXED, __HIP_MEMORY_SCOPE_AGENT
constexpr int CW_BAR = 4096;
#define XB_TMO      128
#define XB_XCNT(j)  (256  + 64 * (j))
#define XB_XSUB(j)  (1280 + 64 * (j))
#define XB_XGEN(j)  (2304 + 64 * (j))
#define XB_TOP      3328
#define XB_TOPGEN   3392
#define XCD_BAR_WORDS 3456
#define XB_SPIN_CAP (1u << 18)

__device__ __forceinline__ unsigned xb_ld(unsigned* p)              { return __hip_atomic_load(p, __ATOMIC_RELAXED, __HIP_MEMORY_SCOPE_AGENT); }
__device__ __forceinline__ unsigned xb_add(unsigned* p, unsigned v) { return __hip_atomic_fetch_add(p, v, __ATOMIC_RELAXED, __HIP_MEMORY_SCOPE_AGENT); }
__device__ __forceinline__ unsigned xb_xcc_id() { return (unsigned)__builtin_amdgcn_s_getreg((3 << 11) | 20) & 0xFu; }
#define XB_SPIN(cond, bar) do { unsigned _sp = 0; while (cond) { __builtin_amdgcn_s_sleep(1); \
    if ((++_sp & 255u) == 0u) { if (xb_ld(&(bar)[XB_TMO])) break; if (_sp > XB_SPIN_CAP) { atomicAdd(&(bar)[XB_TMO], 1u); break; } } } } while (0)

struct XcdBarrier {
    unsigned* bar; unsigned x;
    volatile LAS unsigned* st;
};

__device__ __forceinline__ XcdBarrier xcd_barrier_post(unsigned* bar, volatile LAS unsigned* st) {
    XcdBarrier b; b.bar = bar; b.x = xb_xcc_id(); b.st = st;
    if (threadIdx.x == 0) (void)xb_add(&bar[XB_XCNT(b.x)], 1u);
    return b;
}
__device__ __forceinline__ void xcd_barrier_complete(unsigned* bar, unsigned x, unsigned& nloc, unsigned& nx) {
    const unsigned G = gridDim.x * gridDim.y * gridDim.z;
    unsigned sum, cnt, mine, sp = 0u;
    for (;;) {
        sum = 0u; cnt = 0u; mine = 0u;
#pragma unroll
        for (unsigned j = 0; j < 16; ++j) { const unsigned c = xb_ld(&bar[XB_XCNT(j)]); sum += c; cnt += (c > 0u) ? 1u : 0u; mine = (j == x) ? c : mine; }
        if (sum == G) break;
        __builtin_amdgcn_s_sleep(1);
        if ((++sp & 255u) == 0u) { if (xb_ld(&bar[XB_TMO])) break; if (sp > XB_SPIN_CAP) { atomicAdd(&bar[XB_TMO], 1u); break; } }
    }
    nloc = mine > 0u ? mine : 1u; nx = cnt > 0u ? cnt : 1u;
}

__device__ __forceinline__ void xcd_barrier(const XcdBarrier& b) {
    asm volatile("s_waitcnt vmcnt(0)" ::: "memory");
    __syncthreads();
    if (threadIdx.x == 0) {
        unsigned* bar = b.bar;
        __builtin_amdgcn_s_waitcnt(0);
        unsigned nloc = b.st[0], nx = b.st[1];
        if (nloc == 0u) { xcd_barrier_complete(bar, b.x, nloc, nx); b.st[0] = nloc; b.st[1] = nx; }
        const unsigned old = xb_add(&bar[XB_XSUB(b.x)], 1u);
        const unsigned gen = old / nloc;
        if (old + 1u == (gen + 1u) * nloc) {
            __builtin_amdgcn_fence(__ATOMIC_RELEASE, "agent");
            asm volatile("s_waitcnt vmcnt(0)" ::: "memory");
            const unsigned og = xb_add(&bar[XB_TOP], 1u);
            const unsigned tg = og / nx;
            if (og + 1u == (tg + 1u) * nx) xb_add(&bar[XB_TOPGEN], 1u);
            else XB_SPIN(xb_ld(&bar[XB_TOPGEN]) == tg, bar);
            __builtin_amdgcn_fence(__ATOMIC_ACQUIRE, "agent");
            xb_add(&bar[XB_XGEN(b.x)], 1u);
            asm volatile("s_waitcnt vmcnt(0)" ::: "memory");
        } else {
            XB_SPIN(xb_ld(&bar[XB_XGEN(b.x)]) == gen, bar);
            __builtin_amdgcn_fence(__ATOMIC_ACQUIRE, "agent");
            asm volatile("s_waitcnt vmcnt(0)" ::: "memory");
        }
    }
    __syncthreads();
}

__global__ void __launch_bounds__(NWAVES * 64, 2) trunk_fwd(Args args) {
    extern __shared__ __attribute__((aligned(16))) unsigned char lds[];
    cg::grid_group grid = cg::this_grid();
    LAS unsigned char* L = (LAS unsigned char*)lds;
#define tid (opq_v((int)threadIdx.x))
#define lane (opq_v((int)threadIdx.x) & 63)
#define wave (__builtin_amdgcn_readfirstlane(opq_v((int)threadIdx.x) >> 6))
#define G (opq_s((int)gridDim.x))
#define bx (opq_s((int)blockIdx.x))
#define vcu (((int)gridDim.x % 8 == 0) ? (bx % 8) * ((int)gridDim.x / 8) + bx / 8 : bx)
#define gw (vcu * NWAVES + wave)
#define NGW (G * NWAVES)
    PTab PT = (PTab)(L + RING_BYTES);
    if (threadIdx.x == 0) {
#pragma unroll
        for (int i = 0; i < 13; ++i) PT[i] = (unsigned long long)args.in[i];
        PT[13] = (unsigned long long)args.out; PT[14] = (unsigned long long)args.ws;
    }
    __syncthreads();
    volatile LAS unsigned* xb_st = (volatile LAS unsigned*)(L + RING_BYTES + 256);
    if (threadIdx.x == 0) { xb_st[0] = 0u; xb_st[1] = 0u; }
    __syncthreads();
    (void)xcd_barrier_post((unsigned*)(ptab_ws(PT) + WS_CTL) + CW_BAR, xb_st);
#define GRID_SYNC() do { XcdBarrier b_; b_.bar = (unsigned*)(ptab_ws(PT) + WS_CTL) + CW_BAR; b_.x = xb_xcc_id(); b_.st = (volatile LAS unsigned*)(L + RING_BYTES + 256); xcd_barrier(b_); } while (0)
#define WSB(T, off) ((T*)(ptab_ws(PT) + (off)))

    convert_layer(PT, 0, L, gw, NGW, wave, lane, 1);
    p0_rows(ptab_in(PT, 0), WSB(bf16, WS_XB), WSB(float, WS_RS), gw, NGW, lane);
    GRID_SYNC();
    if (gridDim.y == 0xFFFFu) grid.sync();

#pragma unroll 1
    for (int li = 0; li < DEPTH; ++li) {
        const int j = li >> 1;
        if ((li & 1) == 0) {
            { pg8::Gemm gm{WSB(bf16, WS_XB), WSB(bf16, WS_WIN), M, 3 * D, D}; pg8::StaticOrder S; S.init(M, 3 * D, G, bx);
              pg8::EpiBf16<0> E{WSB(bf16, WS_QO), D, D, (size_t)(WS_K - WS_QO) / 2, attn_body::C2, nullptr, WSB(float, WS_RS), WSB(unsigned, WS_CTL) + CW_QKMAX + j * 128};
              pg8::gemm_phase<pg8::EpiBf16<0>, pg8::StaticOrder, true, true>(L + RING_OFF, gm, S, E); }
            logit_phase(WSB(bf16, WS_XB), WSB(bf16, WS_WIN) + (size_t)3 * D * D, WSB(float, WS_RS), WSB(float, WS_FLOG), gw, NGW, lane);
            if (li == 0) convert_layer(PT, 0, L, gw, NGW, wave, lane, 2);
            GRID_SYNC();
            if (bx >= 32) {
                p_phase(ptab_in(PT, 1) + (size_t)li * M * PLE, WSB(bf16, WS_PB), (bx - 32) * NWAVES + wave, (G - 32) * NWAVES, lane);
                p_phase(ptab_in(PT, 1) + (size_t)(li + 1) * M * PLE, WSB(bf16, WS_PB2), (bx - 32) * NWAVES + wave, (G - 32) * NWAVES, lane); }
            gate_phase(WSB(float, WS_FLOG), ptab_in(PT, 4) + j * H, WSB(float, WS_C2), nullptr, WSB(bf16, WS_QO), WSB(bf16, WS_K), L, G, tid, wave, lane);
            GRID_SYNC();
            volatile LAS int* wq_ = (volatile LAS int*)(L + RING_BYTES + 512);
            for (;;) {
                if (wave == 0 && lane == 0) *wq_ = (int)__hip_atomic_fetch_add(WSB(unsigned, WS_CTL) + CW_ATTQ + j * 64, 1u, __ATOMIC_RELAXED, __HIP_MEMORY_SCOPE_AGENT);
                __syncthreads();
                const int u = __builtin_amdgcn_readfirstlane(*wq_);
                __syncthreads();
                if (u >= BATCH * H * (SEQ / 256)) break;
                const int bh = u >> 6, qb = u & 63;
                unsigned* qkmax = WSB(unsigned, WS_CTL) + CW_QKMAX + j * 128 + bh * 4;
                const float qm = __uint_as_float(__hip_atomic_load(qkmax + 0, __ATOMIC_RELAXED, __HIP_MEMORY_SCOPE_AGENT)) + __uint_as_float(__hip_atomic_load(qkmax + 1, __ATOMIC_RELAXED, __HIP_MEMORY_SCOPE_AGENT));
                const float km = __uint_as_float(__hip_atomic_load(qkmax + 2, __ATOMIC_RELAXED, __HIP_MEMORY_SCOPE_AGENT)) + __uint_as_float(__hip_atomic_load(qkmax + 3, __ATOMIC_RELAXED, __HIP_MEMORY_SCOPE_AGENT));
                const float bnd = sqrtf(qm * km) * 1.02f + 1.0f;
                attn_body::fox_unit(bh >> 4, bh & 15, qb, (const attn_body::bf16*)WSB(bf16, WS_QO), (const attn_body::bf16*)WSB(bf16, WS_K), (const attn_body::bf16*)WSB(bf16, WS_V), (attn_body::bf16*)WSB(bf16, WS_QO), WSB(float, WS_C2) + (size_t)bh * SEQ, bnd, (char*)lds + RING_OFF);
            }
            GRID_SYNC();
        } else {
            { pg8::Gemm gm{WSB(bf16, WS_XB), WSB(bf16, WS_WIN), M, 3 * D, D}; pg8::StaticOrder S; S.init(M, 3 * D, G, bx);
              pg8::EpiBf16<4> E{WSB(bf16, WS_QO), D, D, (size_t)(WS_K - WS_QO) / 2, 1.f, nullptr, WSB(float, WS_RS), nullptr};
              pg8::gemm_phase<pg8::EpiBf16<4>, pg8::StaticOrder, true, true>(L + RING_OFF, gm, S, E); }
            GRID_SYNC();
            conv_phase(WSB(bf16, WS_QO), WSB(bf16, WS_K), WSB(bf16, WS_QO), ptab_in(PT, 7) + (size_t)j * 3 * D, vcu * NWAVES * 64 + tid, G * NWAVES * 64);
            GRID_SYNC();
        }
#define FUSED_GEMM(Aoff, Woff, KK, MUL, GA, IDX) do { \
            pg8::Gemm gm{WSB(bf16, Aoff), WSB(bf16, Woff), M, D, KK}; pg8::StaticOrder S; S.init(M, D, G, bx); \
            const unsigned want_ = 32u * (unsigned)(li * 3 + (IDX) + 1); unsigned* ctl_ = WSB(unsigned, WS_CTL); \
            pg8::PanelRms s1_{WSB(unsigned, WS_X1), ctl_ + CW_SEAM, ctl_ + CW_TMO, want_, RMS_EPS, nullptr}, s2_{WSB(unsigned, WS_X2), ctl_ + CW_SEAM + SEAM_BANK, ctl_ + CW_TMO, want_, RMS_EPS, WSB(float, WS_RS)}; \
            const bool first_ = (li == 0 && (IDX) == 0), last_ = (li + 1 == DEPTH && (IDX) == 2); \
            pg8::EpiRms E{first_ ? (const void*)ptab_in(PT, 0) : (const void*)WSB(bf16, WS_XB), last_ ? (void*)ptab_out(PT) : (void*)WSB(bf16, WS_XB), MUL, GA, D, s1_, s2_, first_ ? 1 : 0, last_ ? 1 : 0, last_ ? 0 : 1}; \
            _Pragma("unroll 1") for (int rd_ = 0; rd_ < 2; ++rd_) { pg8::RoundOrder R{S, rd_}; pg8::gemm_phase<pg8::EpiRms, pg8::RoundOrder, false, true>(L + RING_OFF, gm, R, E); } } while (0)
        { const float* g = ptab_in(PT, 2) + (size_t)li * 6 * D;
          FUSED_GEMM(WS_QO, WS_WOUT, D, (const bf16*)nullptr, g + D, 0); }
        GRID_SYNC();
        { pg8::Gemm gm{WSB(bf16, WS_XB), WSB(bf16, WS_WUP), M, FF, D}; pg8::StaticOrder S; S.init(M, FF, G, bx);
          pg8::EpiBf16<2> E{WSB(bf16, WS_H), FF, 0, 0, 1.f, nullptr, WSB(float, WS_RS), nullptr};
          pg8::gemm_phase<pg8::EpiBf16<2>, pg8::StaticOrder, true, true>(L + RING_OFF, gm, S, E); }
        GRID_SYNC();
        { const float* g = ptab_in(PT, 2) + (size_t)li * 6 * D;
          FUSED_GEMM(WS_H, WS_WDN, FF, (const bf16*)nullptr, g + 3 * D, 1); }
        GRID_SYNC();
        { pg8::Gemm gm{WSB(bf16, WS_XB), WSB(bf16, WS_WG + (li & 1) * WS_WALT), M, D, D}; pg8::StaticOrder S; S.init(M, D, G, bx);
          pg8::EpiBf16<3> E{WSB(bf16, WS_Y), D, 0, 0, 1.f, nullptr, WSB(float, WS_RS), nullptr};
          pg8::gemm_phase<pg8::EpiBf16<3>, pg8::StaticOrder, true, true>(L + RING_OFF, gm, S, E); }
        { const float* g = ptab_in(PT, 2) + (size_t)li * 6 * D;
          FUSED_GEMM(((li & 1) ? WS_PB2 : WS_PB), WS_WP + (li & 1) * WS_WALT, PLE, (const bf16*)WSB(bf16, WS_Y), g + 5 * D, 2); }
        if (li + 1 < DEPTH) { convert_layer(PT, li + 1, L, gw, NGW, wave, lane); GRID_SYNC(); }
    }
#undef tid
#undef lane
#undef wave
#undef G
#undef bx
#undef vcu
#undef gw
#undef NGW
}

extern "C" void kernel_launch(void* const* d_in, const int* in_sizes, int n_in, void* d_out, int out_size, void* d_ws, size_t ws_size, hipStream_t stream) {
    static int grid = 0;
    if (grid == 0) {
        if (n_in != 13 || in_sizes[0] != M * D || out_size != M * D || ws_size < WS_END) { fprintf(stderr, "kernel_launch: unexpected shapes (n_in %d, in0 %d, out %d, ws %zu)\n", n_in, n_in > 0 ? in_sizes[0] : -1, out_size, ws_size); grid = -1; return; }
        int dev = 0, cus = 0, per_cu = 0;
        if (hipGetDevice(&dev) != hipSuccess || hipDeviceGetAttribute(&cus, hipDeviceAttributeMultiprocessorCount, dev) != hipSuccess) { grid = -1; return; }
        if (hipFuncSetAttribute((const void*)trunk_fwd, hipFuncAttributeMaxDynamicSharedMemorySize, LDS_BYTES) != hipSuccess) { fprintf(stderr, "kernel_launch: hipFuncSetAttribute failed\n"); grid = -1; return; }
        if (hipOccupancyMaxActiveBlocksPerMultiprocessor(&per_cu, (const void*)trunk_fwd, NWAVES * 64, LDS_BYTES) != hipSuccess || per_cu < 1) { fprintf(stderr, "kernel_launch: occupancy query says %d\n", per_cu); per_cu = 1; }
        (void)hipGetLastError();
        grid = cus * per_cu;
    }
    if (grid < 0) return;
    (void)hipMemsetAsync((char*)d_ws + WS_CTL, 0, CTL_ZERO_BYTES, stream);
    Args a{};
    for (int i = 0; i < 13; ++i) a.in[i] = (const float*)d_in[i];
    a.out = (float*)d_out; a.ws = (unsigned char*)d_ws;
    void* kargs[] = {&a};
    hipError_t e = hipLaunchCooperativeKernel((const void*)trunk_fwd, dim3(grid), dim3(NWAVES * 64), kargs, LDS_BYTES, stream);
    if (e != hipSuccess) fprintf(stderr, "cooperative launch failed: %s (grid %d)\n", hipGetErrorString(e), grid);
}
```

```cpp
#include <hip/hip_runtime.h>
#include <hip/hip_cooperative_groups.h>
#include <cstdio>
#include <cstdint>
namespace cg = cooperative_groups;
__device__ __forceinline__ int opq_v(int v) { asm volatile("" : "+v"(v)); return v; }
__device__ __forceinline__ int opq_s(int v) { asm volatile("" : "+s"(v)); return v; }
__device__ __forceinline__ float shflx_f(float v, int mask, int lane) { return __int_as_float(__builtin_amdgcn_ds_bpermute((lane ^ mask) << 2, __float_as_int(v))); }
__device__ __forceinline__ int shflx_i(int v, int mask, int lane) { return __builtin_amdgcn_ds_bpermute((lane ^ mask) << 2, v); }
__device__ __forceinline__ float sum_rows4(float v) {
    auto a = __builtin_amdgcn_permlane16_swap(__float_as_uint(v), __float_as_uint(v), false, false); v = __uint_as_float(a[0]) + __uint_as_float(a[1]);
    auto b = __builtin_amdgcn_permlane32_swap(__float_as_uint(v), __float_as_uint(v), false, false); return __uint_as_float(b[0]) + __uint_as_float(b[1]);
}
namespace pg8 {
#define PG8_LAS __attribute__((address_space(3)))
typedef unsigned short bf16_t;
typedef short bf16x8 __attribute__((ext_vector_type(8)));
typedef float f32x4 __attribute__((ext_vector_type(4)));
typedef unsigned u32x4 __attribute__((ext_vector_type(4)));
constexpr int BM = 256, BK = 64, HALF = 128, HTB = HALF * BK * 2  , STAGE_BYTES = 8 * HTB, NXCD = 8, WGM = 8;

__host__ __device__ __forceinline__ int lds_byte(int r, int c) { const int st = (r >> 4) * 2 + (c >> 5), rr = r & 15, cc = c & 31, ob = rr * 64 + cc * 2; return st * 1024 + (ob ^ (((ob >> 9) & 1) << 5)); }
__host__ __device__ __forceinline__ void stage_rc(int b, int& R, int& C) { const int st = b / 1024, sb = b % 1024, swz = sb ^ (((sb >> 9) & 1) << 5); R = (st >> 1) * 16 + swz / 64; C = (st & 1) * 32 + (swz % 64) / 2; }
__host__ __device__ __forceinline__ int perm32(int rho) { const int n = rho >> 4, i = rho & 15; return 8 * (i >> 2) + 4 * n + (i & 3); }

struct Unit { int pm, pn; };
struct Gemm { const bf16_t* A; const bf16_t* Bt; int M, N, K; };

struct StaticOrder {
    int nM, nN, nwg, G, c;
    __host__ __device__ void init(int M, int N, int G_, int c_) { nM = M / BM; nN = N / BM; nwg = nM * nN; G = G_; c = c_; }
    __host__ __device__ bool next(int i, Unit& u) const {
        const long L = (long)i * G + c; if (L >= nwg) return false;
        int wgid = (int)L; { const int q = nwg / NXCD, r = nwg % NXCD, xcd = wgid % NXCD, off = wgid / NXCD; wgid = (xcd < r ? xcd * (q + 1) : r * (q + 1) + (xcd - r) * q) + off; }
        const int nig = WGM * nN, gid = wgid / nig, fm = gid * WGM, gsz = (nM - fm) < WGM ? (nM - fm) : WGM;
        u.pm = fm + ((wgid % nig) % gsz); u.pn = (wgid % nig) / gsz; return true;
    }
    __device__ __forceinline__ void a_ready(const Unit&) const {}
    __device__ __forceinline__ void done(const Unit&) const {}
};

__device__ __forceinline__ unsigned cvt_pk_bf16(float lo, float hi) { unsigned r; asm volatile("v_cvt_pk_bf16_f32 %0, %1, %2" : "=v"(r) : "v"(lo), "v"(hi)); return r; }
typedef float f32x2 __attribute__((ext_vector_type(2)));
typedef float f32x2 __attribute__((ext_vector_type(2)));
template <int ACT  > struct EpiBf16 {
    static constexpr bool PERM = true, AFTER_DRAIN = false, ADJ = true;
    bf16_t* O; int ldc; int split_cols; size_t split_stride; float scale0; float* flog; const float* rs; unsigned* qkm;
    __device__ __forceinline__ void operator()(const f32x4 (&acc)[2][2][4][2], const Unit& u, int wr, int wc, int fr, int fq) const {
        const int row0 = u.pm * BM + wr * 64 + fr; int colt = u.pn * BM; bf16_t* base = O;
        float sc = 1.f; int t = 0;
        if (split_cols) { t = colt / split_cols; base += (size_t)t * split_stride; colt -= t * split_cols; if (t == 0) sc = scale0; }
        if (t == 3) {
            if (wc == 0 && fq < 2) {
#pragma unroll
                for (int ai = 0; ai < 2; ++ai)
#pragma unroll
                    for (int m = 0; m < 4; ++m) { float* rp = flog + (size_t)(row0 + ai * HALF + m * 16) * 16 + 8 * fq; *(f32x4*)rp = acc[ai][0][m][0]; *(f32x4*)(rp + 4) = acc[ai][0][m][1]; }
            }
            return;
        }
        const int col0 = colt + wc * 64 + 8 * fq; const int lane_ = fq * 16 + fr;
        const bool trk = ACT == 0 && qkm != nullptr && t < 2; float cm0 = 0.f, cm1 = 0.f;
        if (ACT == 4 && t >= 1) {
            bf16_t* zb = O + split_stride + (size_t)row0 * ldc + (u.pn - 4) * 128 + wc * 32 + fq * 8;
#pragma unroll
            for (int ai = 0; ai < 2; ++ai)
#pragma unroll
                for (int m = 0; m < 4; ++m) { const float r2 = rs[row0 + ai * HALF + m * 16]; const float rr = r2 * r2;
                    const f32x4 z0 = acc[ai][0][m][0] * acc[ai][0][m][1] * rr, z1 = acc[ai][1][m][0] * acc[ai][1][m][1] * rr;
                    u32x4 w; w.x = cvt_pk_bf16(z0[0], z0[1]); w.y = cvt_pk_bf16(z0[2], z0[3]); w.z = cvt_pk_bf16(z1[0], z1[1]); w.w = cvt_pk_bf16(z1[2], z1[3]);
                    *(u32x4*)(zb + (size_t)(ai * HALF + m * 16) * ldc) = w; }
            return;
        }
        float rsv[2][4];
#pragma unroll
        for (int ai = 0; ai < 2; ++ai)
#pragma unroll
            for (int m = 0; m < 4; ++m) rsv[ai][m] = rs[row0 + ai * HALF + m * 16];
#pragma unroll
        for (int ai = 0; ai < 2; ++ai)
#pragma unroll
            for (int m = 0; m < 4; ++m) { bf16_t* rowp = base + (size_t)(row0 + ai * HALF + m * 16) * ldc + col0;
#pragma unroll
                for (int bj = 0; bj < 2; ++bj) { f32x4 v0 = acc[ai][bj][m][0] * rsv[ai][m], v1 = acc[ai][bj][m][1] * rsv[ai][m];
                    if (ACT == 3) {
#pragma unroll
                        for (int i = 0; i < 4; ++i) { v0[i] = 1.f / (1.f + __expf(-v0[i])); v1[i] = 1.f / (1.f + __expf(-v1[i])); } }
                    if (ACT == 2) {
#pragma unroll
                        for (int i = 0; i < 4; ++i) { const float a = fmaxf(v0[i], 0.f), b = fmaxf(v1[i], 0.f); v0[i] = a * a; v1[i] = b * b; } }
                    v0 = v0 * sc; v1 = v1 * sc; u32x4 w; w.x = cvt_pk_bf16(v0[0], v0[1]); w.y = cvt_pk_bf16(v0[2], v0[3]); w.z = cvt_pk_bf16(v1[0], v1[1]); w.w = cvt_pk_bf16(v1[2], v1[3]);
                    *(u32x4*)(rowp + bj * 32) = w;
                    if (trk) { float q = ((v0[0] * v0[0] + v0[1] * v0[1]) + (v0[2] * v0[2] + v0[3] * v0[3])) + ((v1[0] * v1[0] + v1[1] * v1[1]) + (v1[2] * v1[2] + v1[3] * v1[3]));
                        q = sum_rows4(q);
                        if (bj == 0) cm0 = fmaxf(cm0, q); else cm1 = fmaxf(cm1, q); } } }
        if (trk) {
#pragma unroll
            for (int o = 1; o < 16; o <<= 1) { cm0 = fmaxf(cm0, shflx_f(cm0, o, lane_)); cm1 = fmaxf(cm1, shflx_f(cm1, o, lane_)); }
            if (lane_ == 0) { const int b = (u.pm * BM) >> 14, hd = (colt >> 6) + wc;
                __hip_atomic_fetch_max(qkm + ((b * 16 + hd) * 2 + t) * 2 + 0, __float_as_uint(cm0), __ATOMIC_RELAXED, __HIP_MEMORY_SCOPE_AGENT);
                __hip_atomic_fetch_max(qkm + ((b * 16 + hd) * 2 + t) * 2 + 1, __float_as_uint(cm1), __ATOMIC_RELAXED, __HIP_MEMORY_SCOPE_AGENT); }
        }
    }
};
struct PanelRms {
    unsigned* xbuf;
    unsigned* cnt;
    unsigned* tmo;
    unsigned want; float eps; float* rsout;
    __device__ __forceinline__ void run(const f32x4 (&v)[2][2][4][2], const Unit& u, int wr, int wc, int fr, int fq, PG8_LAS unsigned char* lds, int wid, int lane) const {
        PG8_LAS float* P = (PG8_LAS float*)lds;
        PG8_LAS float* S = (PG8_LAS float*)(lds + 8192);
#pragma unroll
        for (int ai = 0; ai < 2; ++ai)
#pragma unroll
            for (int m = 0; m < 4; ++m) {
                float q = 0.f;
#pragma unroll
                for (int bj = 0; bj < 2; ++bj)
#pragma unroll
                    for (int n = 0; n < 2; ++n) { const f32x4 x = v[ai][bj][m][n]; q += (x[0] * x[0] + x[1] * x[1]) + (x[2] * x[2] + x[3] * x[3]); }
                q = sum_rows4(q);
                if (fq == 0) P[(ai * HALF + wr * 64 + m * 16 + fr) * 4 + wc] = q;
            }
        asm volatile("s_waitcnt lgkmcnt(0)" ::: "memory"); __builtin_amdgcn_s_barrier(); asm volatile("" ::: "memory");
        const int row = wid * 32 + (lane & 31);
        if (lane < 32) {
            const f32x4 p = *(const PG8_LAS f32x4*)(P + row * 4);
            __hip_atomic_store(xbuf + ((size_t)(u.pm * BM + row) * 4 + u.pn), __float_as_uint((p[0] + p[1]) + (p[2] + p[3])), __ATOMIC_RELAXED, __HIP_MEMORY_SCOPE_AGENT);
        }
        asm volatile("s_waitcnt vmcnt(0)" ::: "memory");
        if (lane == 0) __hip_atomic_fetch_add(cnt + 64 * u.pm, 1u, __ATOMIC_RELAXED, __HIP_MEMORY_SCOPE_AGENT);
        if (wid == 0) {
            for (int sp = 0;; ++sp) {
                if ((unsigned)__builtin_amdgcn_readfirstlane(__hip_atomic_load(cnt + 64 * u.pm, __ATOMIC_RELAXED, __HIP_MEMORY_SCOPE_AGENT)) >= want) break;
                if (sp > 65536) { if (lane == 0) __hip_atomic_store(tmo, 1u, __ATOMIC_RELAXED, __HIP_MEMORY_SCOPE_AGENT); break; }
                __builtin_amdgcn_s_sleep(2);
            }
            __builtin_amdgcn_fence(__ATOMIC_ACQUIRE, "agent");
        }
        asm volatile("s_waitcnt vmcnt(0) lgkmcnt(0)" ::: "memory"); __builtin_amdgcn_s_barrier(); asm volatile("" ::: "memory");
        if (lane < 32) {
            const unsigned* slot = xbuf + (size_t)(u.pm * BM + row) * 4; float q = 0.f;
#pragma unroll
            for (int t = 0; t < 4; ++t) q += __uint_as_float(__hip_atomic_load(slot + t, __ATOMIC_RELAXED, __HIP_MEMORY_SCOPE_AGENT));
            const float rstd_ = 1.0f / sqrtf(q * (1.0f / 1024.0f) + eps); S[row] = rstd_;
            if (rsout && u.pn == 0) rsout[u.pm * BM + row] = rstd_;
        }
        asm volatile("s_waitcnt lgkmcnt(0)" ::: "memory"); __builtin_amdgcn_s_barrier(); asm volatile("" ::: "memory");
    }
};
struct EpiRms {
    static constexpr bool PERM = true, AFTER_DRAIN = true, ADJ = false;
    const void* base; void* out; const bf16_t* mul; const float* gA; int ldc; PanelRms st1, st2; int base_f32, out_f32, need_rs;
    __device__ __forceinline__ void fused(f32x4 (&acc)[2][2][4][2], const Unit& u, int wr, int wc, int fr, int fq, PG8_LAS unsigned char* lds, int wid, int lane) const {
        typedef unsigned u32x2v __attribute__((ext_vector_type(2)));
        const PG8_LAS float* S = (const PG8_LAS float*)(lds + 8192);
        const int col0 = u.pn * BM + wc * 32 + 8 * fq;
        const unsigned b0 = (unsigned)((u.pm * BM + wr * 64 + fr) * ldc + col0) * 4u;
#define RMS_OFF(ai, m, bj, n) (b0 + (unsigned)(((ai) * HALF + (m) * 16) * ldc + (bj) * HALF + (n) * 4) * 4u)
#define RMS_UNPK(PK_, lo, hi) do { lo = (f32x4){__uint_as_float((PK_)[0] << 16), __uint_as_float((PK_)[0] & 0xffff0000u), __uint_as_float((PK_)[1] << 16), __uint_as_float((PK_)[1] & 0xffff0000u)}; \
                                   hi = (f32x4){__uint_as_float((PK_)[2] << 16), __uint_as_float((PK_)[2] & 0xffff0000u), __uint_as_float((PK_)[3] << 16), __uint_as_float((PK_)[3] & 0xffff0000u)}; } while (0)
#define RMS_LOADX(ai, m, bj, lo, hi) do { if (base_f32) { lo = *(const f32x4*)((const char*)base + RMS_OFF(ai, m, bj, 0)); hi = *(const f32x4*)((const char*)base + RMS_OFF(ai, m, bj, 1)); } \
                                          else { const u32x4 w_ = *(const u32x4*)((const char*)base + (RMS_OFF(ai, m, bj, 0) >> 1)); RMS_UNPK(w_, lo, hi); } } while (0)
#define RMS_STOREX(ai, m, bj, lo, hi) do { if (out_f32) { *(f32x4*)((char*)out + RMS_OFF(ai, m, bj, 0)) = lo; *(f32x4*)((char*)out + RMS_OFF(ai, m, bj, 1)) = hi; } \
                                           else { u32x4 w_; w_.x = cvt_pk_bf16(lo[0], lo[1]); w_.y = cvt_pk_bf16(lo[2], lo[3]); w_.z = cvt_pk_bf16(hi[0], hi[1]); w_.w = cvt_pk_bf16(hi[2], hi[3]); \
                                                  *(u32x4*)((char*)out + (RMS_OFF(ai, m, bj, 0) >> 1)) = w_; } } while (0)
        if (mul) {
#pragma unroll
            for (int ai = 0; ai < 2; ++ai)
#pragma unroll
                for (int m = 0; m < 4; ++m) {
#pragma unroll
                    for (int bj = 0; bj < 2; ++bj) { const u32x4 w = *(const u32x4*)((const char*)mul + (RMS_OFF(ai, m, bj, 0) >> 1)); f32x4 lo, hi; RMS_UNPK(w, lo, hi);
                        acc[ai][bj][m][0] = acc[ai][bj][m][0] * lo; acc[ai][bj][m][1] = acc[ai][bj][m][1] * hi; }
                    asm volatile("" : "+v"(acc[ai][0][m][0]), "+v"(acc[ai][0][m][1]), "+v"(acc[ai][1][m][0]), "+v"(acc[ai][1][m][1]));
                    if (m & 1) asm volatile("" ::: "memory"); }
        }
        f32x4 pre[2][2][2];
#pragma unroll
        for (int m = 0; m < 2; ++m)
#pragma unroll
            for (int bj = 0; bj < 2; ++bj) RMS_LOADX(0, m, bj, pre[m][bj][0], pre[m][bj][1]);
        f32x4 gpre[2][2];
#pragma unroll
        for (int bj = 0; bj < 2; ++bj)
#pragma unroll
            for (int n = 0; n < 2; ++n) gpre[bj][n] = *(const f32x4*)(gA + col0 + bj * HALF + n * 4);
        st1.run(acc, u, wr, wc, fr, fq, lds, wid, lane);
#pragma unroll
        for (int bj = 0; bj < 2; ++bj)
#pragma unroll
            for (int n = 0; n < 2; ++n) { const f32x4 g = gpre[bj][n];
#pragma unroll
                for (int ai = 0; ai < 2; ++ai)
#pragma unroll
                    for (int m = 0; m < 4; ++m) acc[ai][bj][m][n] = acc[ai][bj][m][n] * g; }
#pragma unroll
        for (int ai = 0; ai < 2; ++ai)
#pragma unroll
            for (int m = 0; m < 4; ++m) { const float sr = S[ai * HALF + wr * 64 + m * 16 + fr];
#pragma unroll
                for (int bj = 0; bj < 2; ++bj) { f32x4 lo, hi;
                    if (ai == 0 && m < 2) { lo = pre[m & 1][bj][0]; hi = pre[m & 1][bj][1]; } else RMS_LOADX(ai, m, bj, lo, hi);
                    acc[ai][bj][m][0] = lo + acc[ai][bj][m][0] * sr; acc[ai][bj][m][1] = hi + acc[ai][bj][m][1] * sr;
                    RMS_STOREX(ai, m, bj, acc[ai][bj][m][0], acc[ai][bj][m][1]); }
                asm volatile("" : "+v"(acc[ai][0][m][0]), "+v"(acc[ai][0][m][1]), "+v"(acc[ai][1][m][0]), "+v"(acc[ai][1][m][1]));
                asm volatile("" ::: "memory"); }
        if (need_rs) st2.run(acc, u, wr, wc, fr, fq, lds, wid, lane);
        asm volatile("s_waitcnt lgkmcnt(0)" ::: "memory"); __builtin_amdgcn_s_barrier(); asm volatile("" ::: "memory");
#undef RMS_OFF
#undef RMS_UNPK
#undef RMS_LOADX
#undef RMS_STOREX
    }
};
struct RoundOrder {
    StaticOrder b; int round;
    __device__ __forceinline__ bool next(int i, Unit& u) const { return i == 0 && b.next(round, u); }
    __device__ __forceinline__ void a_ready(const Unit&) const {}
    __device__ __forceinline__ void done(const Unit&) const {}
};

template <class Epi, class Sched, bool ALIGN_EPI = false, bool SP2 = false>
__device__ __forceinline__ void gemm_phase(PG8_LAS unsigned char* lds, const Gemm g, const Sched& S, const Epi& E) {
    const int tid = opq_v((int)threadIdx.x), wid = __builtin_amdgcn_readfirstlane(tid >> 6), lane = tid & 63, wr = wid >> 2, wc = wid & 3, fr = lane & 15, fq = lane >> 4;
    const int K = g.K, nt = K / BK;
    unsigned voffA[2], voffB[2];
#pragma unroll
    for (int i = 0; i < 2; ++i) { int R, C; stage_rc(tid * 16 + i * 8192, R, C); const int Rb = Epi::ADJ ? (64 * (R >> 5) + perm32(R & 31)) : Epi::PERM ? ((R & ~31) + perm32(R & 31)) : R;
        voffA[i] = (unsigned)(R * K + C) * 2u; voffB[i] = (unsigned)(Rb * K + C) * 2u; }
    const size_t kstep = (size_t)(BK * 2);
    const size_t hstep = (size_t)HALF * K * 2;
    const size_t tstep = 2 * hstep;
    const size_t bhstep = Epi::ADJ ? (size_t)32 * K * 2 : hstep;
    const unsigned ldsw = (unsigned)wid * 1024u;
    const int aoff = lds_byte(wr * 64 + fr, fq * 8), boff = lds_byte(wc * 32 + fr, fq * 8);
#define PG8_SA(b, h) (((b) * 2 + (h)) * HTB)
#define PG8_SB(b, h) ((4 + (b) * 2 + (h)) * HTB)
#define PG8_STAGE(bufoff, gbase, voff) do { _Pragma("unroll") for (int _i = 0; _i < 2; ++_i) \
        __builtin_amdgcn_global_load_lds((const unsigned*)((const char*)(gbase) + (voff)[_i]), (PG8_LAS unsigned*)(lds + (bufoff) + ldsw + _i * 8192), 16, 0, 0); } while (0)
#define PG8_LDA(dst, b, h) do { _Pragma("unroll") for (int m = 0; m < 4; ++m) _Pragma("unroll") for (int k = 0; k < 2; ++k) dst[m][k] = *(const PG8_LAS bf16x8*)(lds + PG8_SA(b, h) + aoff + m * 2048 + k * 1024); } while (0)
#define PG8_LDB(dst, b, h) do { _Pragma("unroll") for (int n = 0; n < 2; ++n) _Pragma("unroll") for (int k = 0; k < 2; ++k) dst[n][k] = *(const PG8_LAS bf16x8*)(lds + PG8_SB(b, h) + boff + n * 2048 + k * 1024); } while (0)
#define PG8_MMA(ai, bj, At, Bt) do { __builtin_amdgcn_s_setprio(1); _Pragma("unroll") for (int m = 0; m < 4; ++m) _Pragma("unroll") for (int n = 0; n < 2; ++n) _Pragma("unroll") for (int k = 0; k < 2; ++k) \
        acc[ai][bj][m][n] = __builtin_amdgcn_mfma_f32_16x16x32_bf16(Bt[n][k], At[m][k], acc[ai][bj][m][n], 0, 0, 0); __builtin_amdgcn_s_setprio(0); } while (0)
#define PG8_WAIT_V(n) asm volatile("s_waitcnt vmcnt(" #n ")" ::: "memory")
#define PG8_WAIT_L(n) asm volatile("s_waitcnt lgkmcnt(" #n ")" ::: "memory")
#define PG8_BAR __builtin_amdgcn_s_barrier()
#define PG8_SCHED __builtin_amdgcn_sched_barrier(0)
    Unit cur, nxt; int ui = 0;
    if (!S.next(0, cur)) return;
    f32x4 acc[2][2][4][2];
#pragma unroll
    for (int a = 0; a < 2; ++a)
#pragma unroll
        for (int b = 0; b < 2; ++b)
#pragma unroll
            for (int m = 0; m < 4; ++m)
#pragma unroll
                for (int n = 0; n < 2; ++n) acc[a][b][m][n] = (f32x4){0.f, 0.f, 0.f, 0.f};
    bf16x8 At[4][2], B0[2][2], B1[2][2];
    const char* cA = (const char*)g.A + (size_t)cur.pm * tstep; const char* cB = (const char*)g.Bt + (size_t)cur.pn * tstep;
    S.a_ready(cur);
    if constexpr (SP2) {
        PG8_STAGE(PG8_SB(0, 0), cB, voffB); PG8_STAGE(PG8_SB(0, 1), cB + bhstep, voffB); PG8_STAGE(PG8_SA(0, 0), cA, voffA); PG8_STAGE(PG8_SA(0, 1), cA + hstep, voffA);
        if (wr == 1) PG8_BAR;
        PG8_WAIT_V(2); PG8_BAR;
        PG8_STAGE(PG8_SB(1, 0), cB + kstep, voffB); PG8_STAGE(PG8_SA(1, 0), cA + kstep, voffA); PG8_STAGE(PG8_SB(1, 1), cB + bhstep + kstep, voffB);
        PG8_WAIT_V(6); PG8_BAR;
    } else {
        PG8_STAGE(PG8_SB(0, 0), cB, voffB); PG8_STAGE(PG8_SA(0, 0), cA, voffA); PG8_STAGE(PG8_SB(0, 1), cB + bhstep, voffB); PG8_STAGE(PG8_SA(0, 1), cA + hstep, voffA);
        if (wr == 1) PG8_BAR;
        PG8_WAIT_V(4); PG8_BAR;
        PG8_STAGE(PG8_SB(1, 0), cB + kstep, voffB); PG8_STAGE(PG8_SA(1, 0), cA + kstep, voffA); PG8_STAGE(PG8_SB(1, 1), cB + bhstep + kstep, voffB);
        PG8_WAIT_V(6); PG8_BAR;
    }
    for (;;) {
        const bool has_next = S.next(ui + 1, nxt);
        const char* nA = has_next ? (const char*)g.A + (size_t)nxt.pm * tstep : cA; const char* nB = has_next ? (const char*)g.Bt + (size_t)nxt.pn * tstep : cB;
        for (int t = 0; t < nt; t += 2) {
            const bool last = (t == nt - 2);
            const char* a1 = cA + (size_t)(t + 1) * kstep;
            const char* a2 = last ? nA : cA + (size_t)(t + 2) * kstep; const char* b2 = last ? nB : cB + (size_t)(t + 2) * kstep;
            const char* a3 = a2 + kstep; const char* b3 = b2 + kstep;
            if (last && has_next) S.a_ready(nxt);
            if constexpr (SP2) {
            PG8_LDB(B0, 0, 0); PG8_LDB(B1, 0, 1); PG8_SCHED; PG8_LDA(At, 0, 0); PG8_STAGE(PG8_SA(1, 1), a1 + hstep, voffA);
            PG8_WAIT_V(8); PG8_WAIT_L(0); PG8_BAR; PG8_MMA(0, 0, At, B0); PG8_MMA(0, 1, At, B1); PG8_BAR; PG8_SCHED;
            PG8_LDA(At, 0, 1); PG8_STAGE(PG8_SB(0, 0), b2, voffB); PG8_STAGE(PG8_SB(0, 1), b2 + bhstep, voffB); PG8_STAGE(PG8_SA(0, 0), a2, voffA);
            PG8_WAIT_V(8); PG8_WAIT_L(0); PG8_BAR; PG8_MMA(1, 0, At, B0); PG8_MMA(1, 1, At, B1); PG8_BAR; PG8_SCHED;
            PG8_LDB(B0, 1, 0); PG8_LDB(B1, 1, 1); PG8_SCHED; PG8_LDA(At, 1, 0); PG8_STAGE(PG8_SA(0, 1), a2 + hstep, voffA);
            PG8_WAIT_V(8); PG8_WAIT_L(0); PG8_BAR; PG8_MMA(0, 0, At, B0); PG8_MMA(0, 1, At, B1); PG8_BAR; PG8_SCHED;
            PG8_LDA(At, 1, 1); PG8_STAGE(PG8_SB(1, 0), b3, voffB); PG8_STAGE(PG8_SB(1, 1), b3 + bhstep, voffB); PG8_STAGE(PG8_SA(1, 0), a3, voffA);
            PG8_WAIT_V(8); PG8_WAIT_L(0); PG8_BAR; PG8_MMA(1, 0, At, B0); PG8_MMA(1, 1, At, B1); PG8_BAR; PG8_SCHED;
            } else {
            PG8_LDB(B0, 0, 0); PG8_SCHED; PG8_LDA(At, 0, 0); PG8_STAGE(PG8_SA(1, 1), a1 + hstep, voffA);
            PG8_WAIT_L(8); PG8_BAR; PG8_WAIT_L(0); PG8_MMA(0, 0, At, B0); PG8_BAR; PG8_SCHED;
            PG8_LDB(B1, 0, 1); PG8_STAGE(PG8_SB(0, 0), b2, voffB);
            PG8_BAR; PG8_WAIT_L(0); PG8_MMA(0, 1, At, B1); PG8_BAR;
            PG8_LDA(At, 0, 1); PG8_STAGE(PG8_SA(0, 0), a2, voffA);
            PG8_BAR; PG8_WAIT_L(0); PG8_MMA(1, 0, At, B0); PG8_BAR; PG8_SCHED;
            PG8_STAGE(PG8_SB(0, 1), b2 + bhstep, voffB);
            PG8_WAIT_V(6); PG8_BAR; PG8_MMA(1, 1, At, B1); PG8_BAR;
            PG8_LDB(B0, 1, 0); PG8_SCHED; PG8_LDA(At, 1, 0); PG8_STAGE(PG8_SA(0, 1), a2 + hstep, voffA);
            PG8_WAIT_L(8); PG8_BAR; PG8_WAIT_L(0); PG8_MMA(0, 0, At, B0); PG8_BAR; PG8_SCHED;
            PG8_LDB(B1, 1, 1); PG8_STAGE(PG8_SB(1, 0), b3, voffB);
            PG8_BAR; PG8_WAIT_L(0); PG8_MMA(0, 1, At, B1); PG8_BAR;
            PG8_LDA(At, 1, 1); PG8_STAGE(PG8_SA(1, 0), a3, voffA);
            PG8_BAR; PG8_WAIT_L(0); PG8_MMA(1, 0, At, B0); PG8_BAR; PG8_SCHED;
            PG8_STAGE(PG8_SB(1, 1), b3 + bhstep, voffB);
            PG8_WAIT_V(6); PG8_BAR; PG8_MMA(1, 1, At, B1); PG8_BAR;
            }
        }
        if constexpr (ALIGN_EPI) { if (wr == 0) PG8_BAR; }
        if constexpr (!Epi::AFTER_DRAIN) { E(acc, cur, wr, wc, fr, fq); S.done(cur); }
        if (!has_next) break;
#pragma unroll
        for (int a = 0; a < 2; ++a)
#pragma unroll
            for (int b = 0; b < 2; ++b)
#pragma unroll
                for (int m = 0; m < 4; ++m)
#pragma unroll
                    for (int n = 0; n < 2; ++n) acc[a][b][m][n] = (f32x4){0.f, 0.f, 0.f, 0.f};
        cur = nxt; cA = nA; cB = nB; ++ui;
        if constexpr (ALIGN_EPI) { if (wr == 1) PG8_BAR; }
    }
    PG8_WAIT_V(0);
    if constexpr (!ALIGN_EPI) { if (wr == 0) PG8_BAR; }
    PG8_BAR;
    if constexpr (Epi::AFTER_DRAIN) { E.fused(acc, cur, wr, wc, fr, fq, lds, wid, lane); S.done(cur); }
#undef PG8_SA
#undef PG8_SB
#undef PG8_STAGE
#undef PG8_LDA
#undef PG8_LDB
#undef PG8_MMA
#undef PG8_WAIT_V
#undef PG8_WAIT_L
#undef PG8_BAR
#undef PG8_SCHED
}
}
#include <hip/hip_bf16.h>
#include <cmath>
namespace attn_body {
using bf16=__hip_bfloat16;
using bf16x8=__attribute__((ext_vector_type(8)))short;
using s16x4=__attribute__((ext_vector_type(4)))short;
using f32x16=__attribute__((ext_vector_type(16)))float;
using u32x4=__attribute__((ext_vector_type(4)))unsigned;
constexpr int BATCH=2,NHEAD=16,SEQ=16384,D=64,DM=NHEAD*D;
constexpr int NW=8,QBLK=32,QB=QBLK*NW,KVBLK=64,NQB=SEQ/QB;
constexpr int ATTN_PITCH=DM, ATTN_UNIT_ROWS=QB;
__device__ __forceinline__ int crow(int r,int hi){return (r&3)+8*(r>>2)+4*hi;}
#define SBAR() __builtin_amdgcn_sched_barrier(0)
__device__ __forceinline__ void cmask(f32x16&p0,f32x16&p1,int jb,int qrel,int hi){
  const float NEG=__int_as_float(opq_s((int)0xff800000)); int kb=64*jb+4*hi;
  #pragma unroll
  for(int r=0;r<16;++r){int kv=kb+(r&3)+8*(r>>2); if(kv>qrel)p0[r]=NEG; if(kv+32>qrel)p1[r]=NEG;}
}

constexpr int NSLOT=3, SLOTB=8192;
constexpr int LDS_K=0, LDS_V=NSLOT*SLOTB, LDS_WS=2*NSLOT*SLOTB, LDS_CK=LDS_WS+NW*64*4, LDS_OST=LDS_CK, LDS_BYTES=LDS_CK+65536;
constexpr float C2=0.125f*1.4426950408889634f;
__device__ __forceinline__ void glds16(const void*gsrc,unsigned lds_dst){unsigned keep;
  asm volatile("s_mov_b32 %0, m0\n\ts_mov_b32 m0, %2\n\ts_nop 0\n\tglobal_load_lds_dwordx4 %1, off\n\ts_mov_b32 m0, %0":"=&s"(keep):"v"(gsrc),"s"(lds_dst):"memory");}
__device__ __forceinline__ float max3f(float a,float b,float c){float r;asm("v_max3_f32 %0, %1, %2, %3":"=v"(r):"v"(a),"v"(b),"v"(c));return r;}
__device__ __forceinline__ float max2f(float a,float b){float r;asm("v_max_f32_e32 %0, %1, %2":"=v"(r):"v"(a),"v"(b));return r;}
__device__ __forceinline__ float fadd_s(float a,float b){float r;asm("v_add_f32_e32 %0, %1, %2":"=v"(r):"v"(a),"v"(b));return r;}
__device__ __forceinline__ float fsub_s(float a,float b){float r;asm("v_sub_f32_e32 %0, %1, %2":"=v"(r):"v"(a),"v"(b));return r;}
typedef float f32x2_t __attribute__((ext_vector_type(2))); typedef __bf16 bf16x2_t __attribute__((ext_vector_type(2)));
__device__ __forceinline__ unsigned cvtpk_s(float lo,float hi){f32x2_t v={lo,hi};bf16x2_t b=__builtin_convertvector(v,bf16x2_t);return __builtin_bit_cast(unsigned,b);}
#define WAIT_BAR(N) asm volatile("s_waitcnt vmcnt(" #N ") lgkmcnt(0)\n\ts_barrier":::"memory")

__device__ __forceinline__ void qkt(f32x16&p0,f32x16&p1,const char*Kslot,const bf16x8*qr,const f32x16&negm,int r32,int hi){
  const char*kb=Kslot+hi*1024+r32*16;
  #pragma unroll
  for(int d0=0;d0<4;++d0){
    const bf16x8 b0=*reinterpret_cast<const bf16x8*>(kb+d0*2048);
    const bf16x8 b1=*reinterpret_cast<const bf16x8*>(kb+d0*2048+512);
    if(d0==0){p0=__builtin_amdgcn_mfma_f32_32x32x16_bf16(b0,qr[0],negm,0,0,0);p1=__builtin_amdgcn_mfma_f32_32x32x16_bf16(b1,qr[0],negm,0,0,0);}
    else{p0=__builtin_amdgcn_mfma_f32_32x32x16_bf16(b0,qr[d0],p0,0,0,0);p1=__builtin_amdgcn_mfma_f32_32x32x16_bf16(b1,qr[d0],p1,0,0,0);}}
}
typedef __attribute__((address_space(3))) const char* lds_cptr;
typedef short v4i16_t __attribute__((ext_vector_type(4)));
__device__ __forceinline__ void kload8(bf16x8*kf,lds_cptr kp){
  kf[0]=*(const __attribute__((address_space(3))) bf16x8*)(kp);      kf[1]=*(const __attribute__((address_space(3))) bf16x8*)(kp+512);
  kf[2]=*(const __attribute__((address_space(3))) bf16x8*)(kp+2048); kf[3]=*(const __attribute__((address_space(3))) bf16x8*)(kp+2560);
  kf[4]=*(const __attribute__((address_space(3))) bf16x8*)(kp+4096); kf[5]=*(const __attribute__((address_space(3))) bf16x8*)(kp+4608);
  kf[6]=*(const __attribute__((address_space(3))) bf16x8*)(kp+6144); kf[7]=*(const __attribute__((address_space(3))) bf16x8*)(kp+6656);
}
__device__ __forceinline__ void kload2(bf16x8*kf,lds_cptr kp,int j){ kf[2*j]=*(const __attribute__((address_space(3))) bf16x8*)(kp+j*2048); kf[2*j+1]=*(const __attribute__((address_space(3))) bf16x8*)(kp+j*2048+512); }
__device__ __forceinline__ s16x4 vtr(lds_cptr p){ return __builtin_bit_cast(s16x4,__builtin_amdgcn_ds_read_tr16_b64_v4i16((__attribute__((address_space(3))) v4i16_t*)p)); }
__device__ __forceinline__ float rowmax(const f32x16&p0,const f32x16&p1){
  float a=max3f(p0[0],p0[1],p1[0]),b=max3f(p0[2],p0[3],p1[1]);a=max3f(a,p1[2],p1[3]);
  #pragma unroll
  for(int r=4;r<16;r+=4){a=max3f(a,p0[r],p0[r+1]);b=max3f(b,p0[r+2],p0[r+3]);a=max3f(a,p1[r],p1[r+1]);b=max3f(b,p1[r+2],p1[r+3]);}
  const float m=max2f(a,b);
  auto rr=__builtin_amdgcn_permlane32_swap(__float_as_uint(m),__float_as_uint(m),false,false);
  return max2f(__uint_as_float(rr[0]),__uint_as_float(rr[1]));
}
__device__ __forceinline__ void pv(f32x16*o,int vb,bf16x8 pa0,bf16x8 pa1,bf16x8 pa2,bf16x8 pa3){
  #pragma unroll
  for(int d0=0;d0<2;++d0){s16x4 lo[4],hi[4];
    #pragma unroll
    for(int ks=0;ks<4;++ks){
      asm volatile("ds_read_b64_tr_b16 %0,%1 offset:%c2":"=&v"(lo[ks]):"v"(vb),"i"(d0*4096+ks*1024):"memory");
      asm volatile("ds_read_b64_tr_b16 %0,%1 offset:%c2":"=&v"(hi[ks]):"v"(vb),"i"(d0*4096+ks*1024+512):"memory");}
    asm volatile("s_waitcnt lgkmcnt(0)":::"memory");SBAR();
    #define PK(k) (bf16x8){lo[k][0],lo[k][1],lo[k][2],lo[k][3],hi[k][0],hi[k][1],hi[k][2],hi[k][3]}
    o[d0]=__builtin_amdgcn_mfma_f32_32x32x16_bf16(pa0,PK(0),o[d0],0,0,0);
    o[d0]=__builtin_amdgcn_mfma_f32_32x32x16_bf16(pa1,PK(1),o[d0],0,0,0);
    o[d0]=__builtin_amdgcn_mfma_f32_32x32x16_bf16(pa2,PK(2),o[d0],0,0,0);
    o[d0]=__builtin_amdgcn_mfma_f32_32x32x16_bf16(pa3,PK(3),o[d0],0,0,0);
    #undef PK
  }
}
constexpr float SKIP_T=40.f;
#ifndef ATTN_STORE16
#define ATTN_STORE16(p,v) (*(u32x4*)(p)=(v))
#endif
typedef float f32x4a __attribute__((ext_vector_type(4)));
__device__ __forceinline__ void fox_unit(int b,int h,int qb,const bf16*Q,const bf16*__restrict__ K,const bf16*__restrict__ V,bf16*O,const float*__restrict__ c2h,float bnd,char*shm){
  const int tid=opq_v((int)threadIdx.x),lane=tid&63,r32=lane&31,hi=lane>>5; const int wid=__builtin_amdgcn_readfirstlane(tid>>6);
  const long rowbase=(long)b*SEQ; const int q0=qb*QB;
  const bf16*Qw=Q+(rowbase+q0+wid*QBLK)*DM+h*D;
  const bf16*Kh=K+rowbase*DM+h*D,*Vh=V+rowbase*DM+h*D;
  const unsigned lds0=(unsigned)(uintptr_t)shm;
  float*wsf=(float*)(shm+LDS_WS)+wid*64;
  float*CK=(float*)(shm+LDS_CK);
  const bf16*ksrc=Kh+(long)lane*DM+wid*8;
  const bf16*vsrc=Vh+(long)(16*(wid&3)+(lane>>2))*DM+(wid>>2)*32+(lane&3)*8;
  const unsigned kdst=lds0+LDS_K+wid*1024, vdst=lds0+LDS_V+wid*1024;
  #define DMA_K(t,slot) glds16(ksrc+(long)(t)*KVBLK*DM,(unsigned)__builtin_amdgcn_readfirstlane(kdst+(slot)))
  #define DMA_V(t,slot) glds16(vsrc+(long)(t)*KVBLK*DM,(unsigned)__builtin_amdgcn_readfirstlane(vdst+(slot)))
  const int vb0=(int)(lds0+LDS_V)+((lane>>4)&1)*32+(lane&3)*8+(4*hi+((lane&15)>>2))*64;
  const char*Kbase=shm+LDS_K;
  const int NT=(q0+QB)/KVBLK;
  const float thr=c2h[q0]+2.f*bnd+SKIP_T;
  int tl=NT-4;
  for(int t=lane;t<NT-4;t+=64){ if(!(c2h[64*t+63]>thr)) tl=min(tl,t); }
  #pragma unroll
  for(int o_=32;o_>=1;o_>>=1) tl=min(tl,shflx_i(tl,o_,lane));
  tl=__builtin_amdgcn_readfirstlane(tl);
  const int n=NT-tl;
  DMA_K(NT-1,0);DMA_V(NT-1,0);
  for(int i=tid*4;i<64*n;i+=NW*64*4) *(f32x4a*)(CK+i)=*(const f32x4a*)(c2h+64*tl+i);
  bf16x8 qr[4];
  #pragma unroll
  for(int d0=0;d0<4;++d0)qr[d0]=*reinterpret_cast<const bf16x8*>(&Qw[(long)r32*DM+d0*16+hi*8]);
  const float cq=c2h[q0+wid*QBLK+r32];
  float mhat=-bnd,l_reg=0.f;f32x16 o[2];o[0]=f32x16{};o[1]=f32x16{};f32x16 negm;
  #pragma unroll
  for(int r=0;r<16;++r)negm[r]=cq-mhat;
  const int qrel=wid*QBLK+r32;
  int sl=0,sl_n=SLOTB;
  for(int it=0;it<n;++it){
    const int t=NT-1-it;
    if(it+1<n){ DMA_K(t-1,sl_n); DMA_V(t-1,sl_n); WAIT_BAR(2); } else { WAIT_BAR(0); }
    if(!(it<4 && 64*(3-it)>32*wid+31)){
    f32x16 p0,p1;
    qkt(p0,p1,Kbase+sl,qr,negm,r32,hi);
    { const float*ckt=CK+(t-tl)*64+4*hi;
      #pragma unroll
      for(int g=0;g<4;++g){ const f32x4a ca=*(const f32x4a*)(ckt+8*g), cb=*(const f32x4a*)(ckt+32+8*g);
        #pragma unroll
        for(int i=0;i<4;++i){ p0[4*g+i]-=ca[i]; p1[4*g+i]-=cb[i]; } } }
    if(it<4)cmask(p0,p1,3-it,qrel,hi);
    float rm;
    { float a=__builtin_fmaxf(p0[0],p1[0]);
      #pragma unroll
      for(int r=1;r<16;++r)a=__builtin_fmaxf(a,__builtin_fmaxf(p0[r],p1[r]));
      auto rr=__builtin_amdgcn_permlane32_swap(__float_as_uint(a),__float_as_uint(a),false,false);
      rm=__builtin_fmaxf(__uint_as_float(rr[0]),__uint_as_float(rr[1])); }
    const float mnew=__builtin_fmaxf(mhat,rm), dl=mnew-mhat;
    if(__any(dl>0.f)){
      const float f=__builtin_amdgcn_exp2f(-dl); l_reg*=f; if(hi==0)wsf[r32]=f;
      asm volatile("s_waitcnt lgkmcnt(0)":::"memory");
      #pragma unroll
      for(int d_=0;d_<2;++d_)
        #pragma unroll
        for(int r=0;r<16;++r)o[d_][r]*=wsf[crow(r,hi)];
      mhat=mnew;
      #pragma unroll
      for(int r=0;r<16;++r){negm[r]=cq-mhat;p0[r]-=dl;p1[r]-=dl;}
    }
    float sacc=0.f;
    #pragma unroll
    for(int r=0;r<16;++r){p0[r]=__builtin_amdgcn_exp2f(p0[r]);p1[r]=__builtin_amdgcn_exp2f(p1[r]);sacc+=p0[r]+p1[r];}
    l_reg+=sacc;
    { u32x4 pw0,pw1,pw2,pw3;
      #define PKW(P,B) cvtpk_s(P[B],P[B+1])
      pw0=(u32x4){PKW(p0,0),PKW(p0,2),PKW(p0,4),PKW(p0,6)};pw1=(u32x4){PKW(p0,8),PKW(p0,10),PKW(p0,12),PKW(p0,14)};pw2=(u32x4){PKW(p1,0),PKW(p1,2),PKW(p1,4),PKW(p1,6)};pw3=(u32x4){PKW(p1,8),PKW(p1,10),PKW(p1,12),PKW(p1,14)};
      #undef PKW
      SBAR(); pv(o,vb0+sl,__builtin_bit_cast(bf16x8,pw0),__builtin_bit_cast(bf16x8,pw1),__builtin_bit_cast(bf16x8,pw2),__builtin_bit_cast(bf16x8,pw3)); }
    }
    sl=sl_n; sl_n=(sl_n==(NSLOT-1)*SLOTB)?0:sl_n+SLOTB;
  }
  asm volatile("s_waitcnt lgkmcnt(0)\n\ts_barrier":::"memory");
  {auto rr=__builtin_amdgcn_permlane32_swap(__float_as_uint(l_reg),__float_as_uint(l_reg),false,false);l_reg=__uint_as_float(rr[0])+__uint_as_float(rr[1]);}
  if(hi==0)wsf[32+r32]=l_reg;asm volatile("s_waitcnt lgkmcnt(0)":::"memory");
  float rli[16];
  #pragma unroll
  for(int r=0;r<16;++r)rli[r]=__builtin_amdgcn_rcpf(wsf[32+crow(r,hi)]);
  bf16*Ow=O+(rowbase+q0+wid*QBLK)*DM+h*D;
  { bf16*stg=(bf16*)(shm+LDS_OST)+wid*2048;
    #pragma unroll
    for(int r=0;r<16;++r){const int orow=crow(r,hi);
      #pragma unroll
      for(int d0=0;d0<2;++d0)stg[orow*64+d0*32+r32]=__float2bfloat16(o[d0][r]*rli[r]);}
    asm volatile("s_waitcnt lgkmcnt(0)":::"memory");
    #pragma unroll
    for(int i=0;i<4;++i){const int row=i*8+(lane>>3),ch=lane&7; const u32x4 v=*(const u32x4*)(stg+row*64+ch*8); ATTN_STORE16(Ow+(long)row*DM+ch*8,v);} }
  asm volatile("s_waitcnt lgkmcnt(0)\n\ts_barrier":::"memory");
  #undef DMA_K
  #undef DMA_V
}
constexpr int ATTN_LDS_BYTES=LDS_BYTES;
#undef SBAR
#undef WAIT_BAR
}
constexpr int NWAVES = 8;
constexpr int BATCH = 2, SEQ = 16384, D = 1024, H = 16, HD = 64, FF = 4096, PLE = 256, DEPTH = 4;
constexpr int M = BATCH * SEQ;
constexpr int NIN_ATT = 3 * D + H;
constexpr float RMS_EPS = 1e-6f;
constexpr float LOG2E = 1.4426950408889634f;
constexpr size_t MiB = 1u << 20;
constexpr size_t WS_CTL = 0, CTL_ZERO_BYTES = 1 * MiB;
constexpr size_t WS_C2 = 1 * MiB, WS_FLOG = 3 * MiB;
constexpr size_t WS_X1 = 5 * MiB, WS_X2 = 6 * MiB, WS_RS = 7 * MiB;
constexpr size_t WS_WIN = 8 * MiB, WS_WOUT = 15 * MiB, WS_WUP = 17 * MiB, WS_WDN = 25 * MiB, WS_WG = 33 * MiB, WS_WP = 35 * MiB, WS_WALT = 3 * MiB;
constexpr size_t WS_PB = 40 * MiB, WS_PB2 = 56 * MiB  , WS_QO = 120 * MiB, WS_K = 184 * MiB, WS_V = 248 * MiB, WS_H = 120 * MiB, WS_Y = 376 * MiB  , WS_XB = 440 * MiB  , WS_END = 504 * MiB;
constexpr int CW_TMO = 0, CW_SEAM = 16384, SEAM_BANK = 128 * 64;
constexpr int CW_ATTQ = 2048;
constexpr int CW_QKMAX = 1024;
constexpr int RING_OFF = 0, RING_BYTES = 131072, LDS_BYTES = 147456;
static_assert(attn_body::ATTN_LDS_BYTES <= RING_BYTES, "attention LDS");

#define GAS __attribute__((address_space(1)))
#define LAS __attribute__((address_space(3)))
typedef unsigned short bf16;
typedef unsigned v4u __attribute__((ext_vector_type(4)));
typedef float f32x4 __attribute__((ext_vector_type(4)));
#define LDS_WAIT() asm volatile("s_waitcnt lgkmcnt(0)" ::: "memory")
__device__ __forceinline__ unsigned f2bf(float f) { unsigned u = __builtin_bit_cast(unsigned, f); return (u + 0x7fffu + ((u >> 16) & 1u)) >> 16; }
__device__ __forceinline__ unsigned pk2(float lo, float hi) { return f2bf(lo) | (f2bf(hi) << 16); }
__device__ __forceinline__ float wave_sum(float v) {
#pragma unroll
    for (int o = 1; o < 64; o <<= 1) v += __shfl_xor(v, o);
    return v;
}
__device__ __forceinline__ void transpose_item(const float* W, int K, int N, int ldn, bf16* WT, int row_off, LAS float* scr, int item, int lane, const float* g = nullptr, int cumode = 0) {
    const int nblk = N / 32, kb = item / nblk, nb = item % nblk, k0 = 64 * kb, n0 = 32 * nb;
    int srcc = n0 + 4 * (lane & 7);
    if (cumode && srcc >= 1024) { const int cu = srcc - 1024, col = cu & 255; srcc = (((col >> 2) & 1) ? 2048 : 1024) + (cu >> 8) * 128 + (col >> 6) * 32 + ((col >> 3) & 3) * 8 + ((col >> 5) & 1) * 4; }
    { f32x4 t[8];
#pragma unroll
      for (int i = 0; i < 8; ++i) t[i] = *(const GAS f32x4*)(W + (size_t)(k0 + 8 * i + (lane >> 3)) * ldn + srcc);
      if (g) {
#pragma unroll
        for (int i = 0; i < 8; ++i) t[i] = t[i] * g[k0 + 8 * i + (lane >> 3)]; }
#pragma unroll
      for (int i = 0; i < 8; ++i) { LAS float* d = scr + (8 * i + (lane >> 3)) * 33 + 4 * (lane & 7); d[0] = t[i].x; d[1] = t[i].y; d[2] = t[i].z; d[3] = t[i].w; } }
    LDS_WAIT(); asm volatile("" ::: "memory");
    const int c = lane & 7;
#pragma unroll
    for (int j = 0; j < 4; ++j) { const int n = (lane >> 3) + 8 * j; const LAS float* s = scr + (8 * c) * 33 + n;
        v4u o; o.x = pk2(s[0 * 33], s[1 * 33]); o.y = pk2(s[2 * 33], s[3 * 33]); o.z = pk2(s[4 * 33], s[5 * 33]); o.w = pk2(s[6 * 33], s[7 * 33]);
        *(GAS v4u*)(WT + (size_t)(row_off + n0 + n) * K + k0 + 8 * c) = o; }
    LDS_WAIT(); asm volatile("" ::: "memory");
}
struct Args { const float* in[13]; float* out; unsigned char* ws; };
typedef volatile LAS unsigned long long* PTab;
__device__ __forceinline__ unsigned long long ptab_raw(PTab PT, int i) { const unsigned a_ = (unsigned)opq_s((int)(unsigned)(size_t)PT + 8 * i);
    const unsigned long long v = *(volatile LAS unsigned long long*)a_; return ((unsigned long long)(unsigned)__builtin_amdgcn_readfirstlane((int)(unsigned)(v >> 32)) << 32) | (unsigned)__builtin_amdgcn_readfirstlane((int)(unsigned)v); }
__device__ __forceinline__ const float* ptab_in(PTab PT, int i) { return (const float*)(const GAS float*)ptab_raw(PT, i); }
__device__ __forceinline__ unsigned char* ptab_ws(PTab PT) { return (unsigned char*)(GAS unsigned char*)ptab_raw(PT, 14); }
__device__ __forceinline__ float* ptab_out(PTab PT) { return (float*)(GAS float*)ptab_raw(PT, 13); }
__device__ __forceinline__ void convert_layer(PTab PT, int li, LAS unsigned char* lds, int gw, int NGW, int wave, int lane_, int part = 0) {
    const int lane = opq_v(lane_);
    LAS float* scr = (LAS float*)(lds + RING_OFF + wave * 16384);
    unsigned char* ws = ptab_ws(PT); const int j = li >> 1; const bool att = (li & 1) == 0;
    const float* Win = att ? ptab_in(PT, 3) + (size_t)j * D * NIN_ATT : ptab_in(PT, 6) + (size_t)j * D * 3 * D; const int ldin = att ? NIN_ATT : 3 * D;
    const float* Wout = att ? ptab_in(PT, 5) + (size_t)j * D * D : ptab_in(PT, 8) + (size_t)j * D * D;
    const float* Wup = ptab_in(PT, 9) + (size_t)li * D * FF; const float* Wdn = ptab_in(PT, 10) + (size_t)li * FF * D;
    const float* Wp = ptab_in(PT, 11) + (size_t)li * PLE * D; const float* Wg = ptab_in(PT, 12) + (size_t)li * D * D;
    const float* gn = ptab_in(PT, 2) + (size_t)li * 6 * D;
    constexpr int I_IN = (D / 64) * (3 * D / 32), I_O = (D / 64) * (D / 32), I_UP = (D / 64) * (FF / 32), I_DN = (FF / 64) * (D / 32), I_G = I_O, I_P = (PLE / 64) * (D / 32), I_F = D / 64;
    const int nF = att ? I_F : 0, NITEMS = I_IN + nF + I_O + I_UP + I_DN + I_G + I_P;
    const int it_lo = part == 2 ? I_IN + nF : 0, it_hi = part == 1 ? I_IN + nF : NITEMS;
    for (int it = it_lo + gw; it < it_hi; it += NGW) {
        int r = it;
        if (r < I_IN) { transpose_item(Win, D, 3 * D, ldin, (bf16*)(ws + WS_WIN), 0, scr, r, lane, gn, att ? 0 : 1); continue; } r -= I_IN;
        if (r < nF) {
            bf16* WT = (bf16*)(ws + WS_WIN);
#pragma unroll 4
            for (int e = lane; e < 64 * 16; e += 64) { const int kk = e >> 4, jj = e & 15; WT[(size_t)(3 * D + jj) * D + 64 * r + kk] = (bf16)f2bf(Win[(size_t)(64 * r + kk) * NIN_ATT + 3 * D + jj] * gn[64 * r + kk]); }
            continue; } r -= nF;
        if (r < I_O) { transpose_item(Wout, D, D, D, (bf16*)(ws + WS_WOUT), 0, scr, r, lane); continue; } r -= I_O;
        if (r < I_UP) { transpose_item(Wup, D, FF, FF, (bf16*)(ws + WS_WUP), 0, scr, r, lane, gn + 2 * D); continue; } r -= I_UP;
        if (r < I_DN) { transpose_item(Wdn, FF, D, D, (bf16*)(ws + WS_WDN), 0, scr, r, lane); continue; } r -= I_DN;
        if (r < I_G) { transpose_item(Wg, D, D, D, (bf16*)(ws + WS_WG + (li & 1) * WS_WALT), 0, scr, r, lane, gn + 4 * D); continue; } r -= I_G;
        transpose_item(Wp, PLE, D, D, (bf16*)(ws + WS_WP + (li & 1) * WS_WALT), 0, scr, r, lane);
    }
}
__device__ __forceinline__ void p0_rows(const float* xsrc, bf16* XBp, float* rs, int gw, int NGW, int lane_) {
    const int lane = opq_v(lane_);
    for (int m = 2 * gw; m < M; m += 2 * NGW) {
        f32x4 v[2][4]; float sq[2];
#pragma unroll
        for (int r = 0; r < 2; ++r) { const GAS f32x4* xr = (const GAS f32x4*)(xsrc + (size_t)(m + r) * D) + lane;
#pragma unroll
            for (int j = 0; j < 4; ++j) v[r][j] = xr[64 * j]; }
#pragma unroll
        for (int r = 0; r < 2; ++r) { sq[r] = 0.f;
#pragma unroll
            for (int j = 0; j < 4; ++j) sq[r] += (v[r][j].x * v[r][j].x + v[r][j].y * v[r][j].y) + (v[r][j].z * v[r][j].z + v[r][j].w * v[r][j].w); }
#pragma unroll
        for (int o = 1; o < 64; o <<= 1) { sq[0] += shflx_f(sq[0], o, lane); sq[1] += shflx_f(sq[1], o, lane); }
#pragma unroll
        for (int r = 0; r < 2; ++r) { if (lane == 0) rs[m + r] = 1.f / sqrtf(sq[r] * (1.f / D) + RMS_EPS);
            GAS unsigned long long* o8 = (GAS unsigned long long*)(XBp + (size_t)(m + r) * D) + lane;
#pragma unroll
            for (int j = 0; j < 4; ++j) o8[64 * j] = (unsigned long long)pk2(v[r][j].x, v[r][j].y) | ((unsigned long long)pk2(v[r][j].z, v[r][j].w) << 32); }
    }
}
__device__ __forceinline__ void p_phase(const float* psrc, bf16* pdst, int gw, int NGW, int lane_) {
    const int lane = opq_v(lane_);
    for (int m = 8 * gw; m < M; m += 8 * NGW) {
        f32x4 q[8];
#pragma unroll
        for (int r = 0; r < 8; ++r) q[r] = ((const GAS f32x4*)(psrc + (size_t)(m + r) * PLE))[lane];
#pragma unroll
        for (int r = 0; r < 8; ++r) ((GAS unsigned long long*)(pdst + (size_t)(m + r) * PLE))[lane] = (unsigned long long)pk2(q[r].x, q[r].y) | ((unsigned long long)pk2(q[r].z, q[r].w) << 32);
    }
}
__device__ __forceinline__ void bf8_to_f32(const v4u w, float (&f)[8]) {
    f[0] = __uint_as_float(w.x << 16); f[1] = __uint_as_float(w.x & 0xffff0000u); f[2] = __uint_as_float(w.y << 16); f[3] = __uint_as_float(w.y & 0xffff0000u);
    f[4] = __uint_as_float(w.z << 16); f[5] = __uint_as_float(w.z & 0xffff0000u); f[6] = __uint_as_float(w.w << 16); f[7] = __uint_as_float(w.w & 0xffff0000u);
}
__device__ __forceinline__ void conv_phase(const bf16* Bq, const bf16* Z, bf16* Yo, const float* cw, int gt_, int NGT) {
    const int gt = opq_v(gt_);
    constexpr int NITEMS = (M / 32) * (D / 8);
    for (int it = gt; it < NITEMS; it += NGT) {
        const int cgp = it & 127, rc = it >> 7, col = cgp * 8, t0 = rc * 32;
        float w0[8], w1[8], w2[8];
#pragma unroll
        for (int i = 0; i < 8; ++i) { w0[i] = cw[col + i]; w1[i] = cw[D + col + i]; w2[i] = cw[2 * D + col + i]; }
        float z1[8], z2[8];
        if ((t0 & (SEQ - 1)) == 0) {
#pragma unroll
            for (int i = 0; i < 8; ++i) { z1[i] = 0.f; z2[i] = 0.f; }
        } else {
            bf8_to_f32(*(const GAS v4u*)(Z + (size_t)(t0 - 1) * D + col), z1); bf8_to_f32(*(const GAS v4u*)(Z + (size_t)(t0 - 2) * D + col), z2);
        }
#pragma unroll 4
        for (int r = 0; r < 32; ++r) {
            const size_t off = (size_t)(t0 + r) * D + col;
            float z[8], bg[8], y[8];
            bf8_to_f32(*(const GAS v4u*)(Z + off), z); bf8_to_f32(*(const GAS v4u*)(Bq + off), bg);
#pragma unroll
            for (int i = 0; i < 8; ++i) { y[i] = bg[i] * (w0[i] * z2[i] + w1[i] * z1[i] + w2[i] * z[i]); z2[i] = z1[i]; z1[i] = z[i]; }
            v4u o; o.x = pk2(y[0], y[1]); o.y = pk2(y[2], y[3]); o.z = pk2(y[4], y[5]); o.w = pk2(y[6], y[7]);
            *(GAS v4u*)(Yo + off) = o;
        }
    }
}
__device__ __forceinline__ void logit_phase(const bf16* XNp, const bf16* Wf, const float* rs, float* flog, int gw, int NGW, int lane_) {
    typedef short bf16x8v __attribute__((ext_vector_type(8)));
    const int lane = opq_v(lane_), fr = lane & 15, fq = lane >> 4;
    for (int blk = gw; blk < M / 16; blk += NGW) {
        const bf16* ap = XNp + (size_t)(blk * 16 + fr) * D + 8 * fq; const bf16* bp = Wf + (size_t)fr * D + 8 * fq;
        f32x4 acc = {0.f, 0.f, 0.f, 0.f};
#pragma unroll 8
        for (int kk = 0; kk < D / 32; ++kk) { const bf16x8v w = *(const GAS bf16x8v*)(bp + 32 * kk), a = *(const GAS bf16x8v*)(ap + 32 * kk); acc = __builtin_amdgcn_mfma_f32_16x16x32_bf16(w, a, acc, 0, 0, 0); }
        acc = acc * rs[blk * 16 + fr];
        { const int row = blk * 16 + fr; float* fo = flog + ((size_t)((row >> 14) * 16 + 4 * fq) << 14) + (row & (SEQ - 1));
#pragma unroll
          for (int i = 0; i < 4; ++i) fo[(size_t)i << 14] = acc[i]; }
    }
}
__device__ __forceinline__ void gate_phase(const float* flog, const float* bfv, float* c2, unsigned* qkmax, const bf16* Q, const bf16* Kb, LAS unsigned char* lds, int G, int tid_, int wave, int lane_) {
    const int tid = opq_v(tid_), lane = opq_v(lane_);
    if (blockIdx.x < 32) {
        const int bh = blockIdx.x, b = bh >> 4, h = bh & 15; const float bias = bfv[h];
        const GAS f32x4* fp = (const GAS f32x4*)(flog + (size_t)bh * SEQ + 32 * tid);
        f32x4 zin[8];
#pragma unroll
        for (int k = 0; k < 8; ++k) zin[k] = fp[k];
        float v[32]; float run = 0.f;
#pragma unroll
        for (int k = 0; k < 32; ++k) { const float z = zin[k >> 2][k & 3] + bias; const float ls = fminf(z, 0.f) - __logf(1.f + __expf(-fabsf(z)));   run += ls; v[k] = run; }
        float incl = run;
#pragma unroll
        for (int o = 1; o < 64; o <<= 1) { const float y = __int_as_float(__builtin_amdgcn_ds_bpermute(((lane - o) & 63) << 2, __float_as_int(incl))); if (lane >= o) incl += y; }
        LAS float* wt = (LAS float*)lds;
        if (lane == 63) wt[wave] = incl;
        __syncthreads();
        float base = 0.f;
        for (int w = 0; w < wave; ++w) base += wt[w];
        const float excl = base + incl - run;
        GAS f32x4* dst = (GAS f32x4*)(c2 + (size_t)bh * SEQ + 32 * tid);
#pragma unroll
        for (int k = 0; k < 8; ++k) dst[k] = (f32x4){(excl + v[4 * k]) * LOG2E, (excl + v[4 * k + 1]) * LOG2E, (excl + v[4 * k + 2]) * LOG2E, (excl + v[4 * k + 3]) * LOG2E};
        __syncthreads();
    } else if (qkmax) {
        LAS unsigned* lm = (LAS unsigned*)lds;
        if (tid < 64) lm[tid] = 0u;
        __syncthreads();
        const int gw = (blockIdx.x - 32) * NWAVES + wave, NGW = (G - 32) * NWAVES;
#pragma unroll
        for (int b = 0; b < 2; ++b) {
            float mq[2] = {0.f, 0.f}, mk[2] = {0.f, 0.f};
            for (int r = 2 * gw; r < SEQ; r += 2 * NGW) {
                const size_t off0 = ((size_t)b * SEQ + r) * D + lane * 8;
                v4u qv[4], kv[4];
#pragma unroll
                for (int j = 0; j < 4; ++j) { qv[j] = *(const GAS v4u*)(Q + off0 + 512 * j); kv[j] = *(const GAS v4u*)(Kb + off0 + 512 * j); }
#pragma unroll
                for (int jj = 0; jj < 4; ++jj) { const int j = jj & 1;
                    float q[8], k[8]; bf8_to_f32(qv[jj], q); bf8_to_f32(kv[jj], k);
                    float sq = 0.f, sk = 0.f;
#pragma unroll
                    for (int i = 0; i < 8; ++i) { sq += q[i] * q[i]; sk += k[i] * k[i]; }
                    sq += shflx_f(sq, 1, lane); sk += shflx_f(sk, 1, lane); sq += shflx_f(sq, 2, lane); sk += shflx_f(sk, 2, lane); sq += shflx_f(sq, 4, lane); sk += shflx_f(sk, 4, lane);
                    mq[j] = fmaxf(mq[j], sq); mk[j] = fmaxf(mk[j], sk);
                }
            }
            if ((lane & 7) == 0) {
#pragma unroll
                for (int j = 0; j < 2; ++j) { const int hh = 8 * j + (lane >> 3); atomicMax((unsigned*)&lm[(b * 16 + hh) * 2], __float_as_uint(mq[j])); atomicMax((unsigned*)&lm[(b * 16 + hh) * 2 + 1], __float_as_uint(mk[j])); }
            }
        }
        __syncthreads();
        if (tid < 64) __hip_atomic_fetch_max(qkmax + tid, lm[tid], __ATOMIC_RELAXED, __HIP_MEMORY_SCOPE_AGENT);
        __syncthreads();
    }
}
#define RLX_AGENT __ATOMIC_RELAXED, __HIP_MEMORY_SCOPE_AGENT
constexpr int CW_BAR = 4096;
#define XB_TMO      128
#define XB_XCNT(j)  (256  + 64 * (j))
#define XB_XSUB(j)  (1280 + 64 * (j))
#define XB_XGEN(j)  (2304 + 64 * (j))
#define XB_TOP      3328
#define XB_TOPGEN   3392
#define XCD_BAR_WORDS 3456
#define XB_SPIN_CAP (1u << 18)

__device__ __forceinline__ unsigned xb_ld(unsigned* p)              { return __hip_atomic_load(p, __ATOMIC_RELAXED, __HIP_MEMORY_SCOPE_AGENT); }
__device__ __forceinline__ unsigned xb_add(unsigned* p, unsigned v) { return __hip_atomic_fetch_add(p, v, __ATOMIC_RELAXED, __HIP_MEMORY_SCOPE_AGENT); }
__device__ __forceinline__ unsigned xb_xcc_id() { return (unsigned)__builtin_amdgcn_s_getreg((3 << 11) | 20) & 0xFu; }
#define XB_SPIN(cond, bar) do { unsigned _sp = 0; while (cond) { __builtin_amdgcn_s_sleep(1); \
    if ((++_sp & 255u) == 0u) { if (xb_ld(&(bar)[XB_TMO])) break; if (_sp > XB_SPIN_CAP) { atomicAdd(&(bar)[XB_TMO], 1u); break; } } } } while (0)

struct XcdBarrier {
    unsigned* bar; unsigned x;
    volatile LAS unsigned* st;
};

__device__ __forceinline__ XcdBarrier xcd_barrier_post(unsigned* bar, volatile LAS unsigned* st) {
    XcdBarrier b; b.bar = bar; b.x = xb_xcc_id(); b.st = st;
    if (threadIdx.x == 0) (void)xb_add(&bar[XB_XCNT(b.x)], 1u);
    return b;
}
__device__ __forceinline__ void xcd_barrier_complete(unsigned* bar, unsigned x, unsigned& nloc, unsigned& nx) {
    const unsigned G = gridDim.x * gridDim.y * gridDim.z;
    unsigned sum, cnt, mine, sp = 0u;
    for (;;) {
        sum = 0u; cnt = 0u; mine = 0u;
#pragma unroll
        for (unsigned j = 0; j < 16; ++j) { const unsigned c = xb_ld(&bar[XB_XCNT(j)]); sum += c; cnt += (c > 0u) ? 1u : 0u; mine = (j == x) ? c : mine; }
        if (sum == G) break;
        __builtin_amdgcn_s_sleep(1);
        if ((++sp & 255u) == 0u) { if (xb_ld(&bar[XB_TMO])) break; if (sp > XB_SPIN_CAP) { atomicAdd(&bar[XB_TMO], 1u); break; } }
    }
    nloc = mine > 0u ? mine : 1u; nx = cnt > 0u ? cnt : 1u;
}

__device__ __forceinline__ void xcd_barrier(const XcdBarrier& b) {
    asm volatile("s_waitcnt vmcnt(0)" ::: "memory");
    __syncthreads();
    if (threadIdx.x == 0) {
        unsigned* bar = b.bar;
        __builtin_amdgcn_s_waitcnt(0);
        unsigned nloc = b.st[0], nx = b.st[1];
        if (nloc == 0u) { xcd_barrier_complete(bar, b.x, nloc, nx); b.st[0] = nloc; b.st[1] = nx; }
        const unsigned old = xb_add(&bar[XB_XSUB(b.x)], 1u);
        const unsigned gen = old / nloc;
        if (old + 1u == (gen + 1u) * nloc) {
            __builtin_amdgcn_fence(__ATOMIC_RELEASE, "agent");
            asm volatile("s_waitcnt vmcnt(0)" ::: "memory");
            const unsigned og = xb_add(&bar[XB_TOP], 1u);
            const unsigned tg = og / nx;
            if (og + 1u == (tg + 1u) * nx) xb_add(&bar[XB_TOPGEN], 1u);
            else XB_SPIN(xb_ld(&bar[XB_TOPGEN]) == tg, bar);
            __builtin_amdgcn_fence(__ATOMIC_ACQUIRE, "agent");
            xb_add(&bar[XB_XGEN(b.x)], 1u);
            asm volatile("s_waitcnt vmcnt(0)" ::: "memory");
        } else {
            __builtin_amdgcn_fence(__ATOMIC_ACQUIRE, "agent");
            asm volatile("s_waitcnt vmcnt(0)" ::: "memory");
            XB_SPIN(xb_ld(&bar[XB_XGEN(b.x)]) == gen, bar);
            asm volatile("" ::: "memory");
            asm volatile("s_waitcnt vmcnt(0)" ::: "memory");
        }
    }
    __syncthreads();
}

__global__ void __launch_bounds__(NWAVES * 64, 2) trunk_fwd(Args args) {
    extern __shared__ __attribute__((aligned(16))) unsigned char lds[];
    cg::grid_group grid = cg::this_grid();
    LAS unsigned char* L = (LAS unsigned char*)lds;
#define tid (opq_v((int)threadIdx.x))
#define lane (opq_v((int)threadIdx.x) & 63)
#define wave (__builtin_amdgcn_readfirstlane(opq_v((int)threadIdx.x) >> 6))
#define G (opq_s((int)gridDim.x))
#define bx (opq_s((int)blockIdx.x))
#define vcu (((int)gridDim.x % 8 == 0) ? (bx % 8) * ((int)gridDim.x / 8) + bx / 8 : bx)
#define gw (vcu * NWAVES + wave)
#define NGW (G * NWAVES)
    PTab PT = (PTab)(L + RING_BYTES);
    if (threadIdx.x == 0) {
#pragma unroll
        for (int i = 0; i < 13; ++i) PT[i] = (unsigned long long)args.in[i];
        PT[13] = (unsigned long long)args.out; PT[14] = (unsigned long long)args.ws;
    }
    __syncthreads();
    volatile LAS unsigned* xb_st = (volatile LAS unsigned*)(L + RING_BYTES + 256);
    if (threadIdx.x == 0) { xb_st[0] = 0u; xb_st[1] = 0u; }
    __syncthreads();
    (void)xcd_barrier_post((unsigned*)(ptab_ws(PT) + WS_CTL) + CW_BAR, xb_st);
#define GRID_SYNC() do { XcdBarrier b_; b_.bar = (unsigned*)(ptab_ws(PT) + WS_CTL) + CW_BAR; b_.x = xb_xcc_id(); b_.st = (volatile LAS unsigned*)(L + RING_BYTES + 256); xcd_barrier(b_); } while (0)
#define WSB(T, off) ((T*)(ptab_ws(PT) + (off)))

    convert_layer(PT, 0, L, gw, NGW, wave, lane, 1);
    p0_rows(ptab_in(PT, 0), WSB(bf16, WS_XB), WSB(float, WS_RS), gw, NGW, lane);
    GRID_SYNC();
    if (gridDim.y == 0xFFFFu) grid.sync();

#pragma unroll 1
    for (int li = 0; li < DEPTH; ++li) {
        const int j = li >> 1;
        if ((li & 1) == 0) {
            { pg8::Gemm gm{WSB(bf16, WS_XB), WSB(bf16, WS_WIN), M, 3 * D, D}; pg8::StaticOrder S; S.init(M, 3 * D, G, bx);
              pg8::EpiBf16<0> E{WSB(bf16, WS_QO), D, D, (size_t)(WS_K - WS_QO) / 2, attn_body::C2, nullptr, WSB(float, WS_RS), WSB(unsigned, WS_CTL) + CW_QKMAX + j * 128};
              pg8::gemm_phase<pg8::EpiBf16<0>, pg8::StaticOrder, true, true>(L + RING_OFF, gm, S, E); }
            logit_phase(WSB(bf16, WS_XB), WSB(bf16, WS_WIN) + (size_t)3 * D * D, WSB(float, WS_RS), WSB(float, WS_FLOG), gw, NGW, lane);
            if (li == 0) convert_layer(PT, 0, L, gw, NGW, wave, lane, 2);
            GRID_SYNC();
            if (bx >= 32) {
                p_phase(ptab_in(PT, 1) + (size_t)li * M * PLE, WSB(bf16, WS_PB), (bx - 32) * NWAVES + wave, (G - 32) * NWAVES, lane);
                p_phase(ptab_in(PT, 1) + (size_t)(li + 1) * M * PLE, WSB(bf16, WS_PB2), (bx - 32) * NWAVES + wave, (G - 32) * NWAVES, lane); }
            gate_phase(WSB(float, WS_FLOG), ptab_in(PT, 4) + j * H, WSB(float, WS_C2), nullptr, WSB(bf16, WS_QO), WSB(bf16, WS_K), L, G, tid, wave, lane);
            GRID_SYNC();
            volatile LAS int* wq_ = (volatile LAS int*)(L + RING_BYTES + 512);
            for (;;) {
                if (wave == 0 && lane == 0) *wq_ = (int)__hip_atomic_fetch_add(WSB(unsigned, WS_CTL) + CW_ATTQ + j * 64, 1u, __ATOMIC_RELAXED, __HIP_MEMORY_SCOPE_AGENT);
                __syncthreads();
                const int u = __builtin_amdgcn_readfirstlane(*wq_);
                __syncthreads();
                if (u >= BATCH * H * (SEQ / 256)) break;
                const int bh = u >> 6, qb = u & 63;
                unsigned* qkmax = WSB(unsigned, WS_CTL) + CW_QKMAX + j * 128 + bh * 4;
                const float qm = __uint_as_float(__hip_atomic_load(qkmax + 0, __ATOMIC_RELAXED, __HIP_MEMORY_SCOPE_AGENT)) + __uint_as_float(__hip_atomic_load(qkmax + 1, __ATOMIC_RELAXED, __HIP_MEMORY_SCOPE_AGENT));
                const float km = __uint_as_float(__hip_atomic_load(qkmax + 2, __ATOMIC_RELAXED, __HIP_MEMORY_SCOPE_AGENT)) + __uint_as_float(__hip_atomic_load(qkmax + 3, __ATOMIC_RELAXED, __HIP_MEMORY_SCOPE_AGENT));
                const float bnd = sqrtf(qm * km) * 1.02f + 1.0f;
                attn_body::fox_unit(bh >> 4, bh & 15, qb, (const attn_body::bf16*)WSB(bf16, WS_QO), (const attn_body::bf16*)WSB(bf16, WS_K), (const attn_body::bf16*)WSB(bf16, WS_V), (attn_body::bf16*)WSB(bf16, WS_QO), WSB(float, WS_C2) + (size_t)bh * SEQ, bnd, (char*)lds + RING_OFF);
            }
            GRID_SYNC();
        } else {
            { pg8::Gemm gm{WSB(bf16, WS_XB), WSB(bf16, WS_WIN), M, 3 * D, D}; pg8::StaticOrder S; S.init(M, 3 * D, G, bx);
              pg8::EpiBf16<4> E{WSB(bf16, WS_QO), D, D, (size_t)(WS_K - WS_QO) / 2, 1.f, nullptr, WSB(float, WS_RS), nullptr};
              pg8::gemm_phase<pg8::EpiBf16<4>, pg8::StaticOrder, true, true>(L + RING_OFF, gm, S, E); }
            GRID_SYNC();
            conv_phase(WSB(bf16, WS_QO), WSB(bf16, WS_K), WSB(bf16, WS_QO), ptab_in(PT, 7) + (size_t)j * 3 * D, vcu * NWAVES * 64 + tid, G * NWAVES * 64);
            GRID_SYNC();
        }
#define FUSED_GEMM(Aoff, Woff, KK, MUL, GA, IDX) do { \
            pg8::Gemm gm{WSB(bf16, Aoff), WSB(bf16, Woff), M, D, KK}; pg8::StaticOrder S; S.init(M, D, G, bx); \
            const unsigned want_ = 32u * (unsigned)(li * 3 + (IDX) + 1); unsigned* ctl_ = WSB(unsigned, WS_CTL); \
            pg8::PanelRms s1_{WSB(unsigned, WS_X1), ctl_ + CW_SEAM, ctl_ + CW_TMO, want_, RMS_EPS, nullptr}, s2_{WSB(unsigned, WS_X2), ctl_ + CW_SEAM + SEAM_BANK, ctl_ + CW_TMO, want_, RMS_EPS, WSB(float, WS_RS)}; \
            const bool first_ = (li == 0 && (IDX) == 0), last_ = (li + 1 == DEPTH && (IDX) == 2); \
            pg8::EpiRms E{first_ ? (const void*)ptab_in(PT, 0) : (const void*)WSB(bf16, WS_XB), last_ ? (void*)ptab_out(PT) : (void*)WSB(bf16, WS_XB), MUL, GA, D, s1_, s2_, first_ ? 1 : 0, last_ ? 1 : 0, last_ ? 0 : 1}; \
            _Pragma("unroll 1") for (int rd_ = 0; rd_ < 2; ++rd_) { pg8::RoundOrder R{S, rd_}; pg8::gemm_phase<pg8::EpiRms, pg8::RoundOrder, false, true>(L + RING_OFF, gm, R, E); } } while (0)
        { const float* g = ptab_in(PT, 2) + (size_t)li * 6 * D;
          FUSED_GEMM(WS_QO, WS_WOUT, D, (const bf16*)nullptr, g + D, 0); }
        GRID_SYNC();
        { pg8::Gemm gm{WSB(bf16, WS_XB), WSB(bf16, WS_WUP), M, FF, D}; pg8::StaticOrder S; S.init(M, FF, G, bx);
          pg8::EpiBf16<2> E{WSB(bf16, WS_H), FF, 0, 0, 1.f, nullptr, WSB(float, WS_RS), nullptr};
          pg8::gemm_phase<pg8::EpiBf16<2>, pg8::StaticOrder, true, true>(L + RING_OFF, gm, S, E); }
        GRID_SYNC();
        { const float* g = ptab_in(PT, 2) + (size_t)li * 6 * D;
          FUSED_GEMM(WS_H, WS_WDN, FF, (const bf16*)nullptr, g + 3 * D, 1); }
        GRID_SYNC();
        { pg8::Gemm gm{WSB(bf16, WS_XB), WSB(bf16, WS_WG + (li & 1) * WS_WALT), M, D, D}; pg8::StaticOrder S; S.init(M, D, G, bx);
          pg8::EpiBf16<3> E{WSB(bf16, WS_Y), D, 0, 0, 1.f, nullptr, WSB(float, WS_RS), nullptr};
          pg8::gemm_phase<pg8::EpiBf16<3>, pg8::StaticOrder, true, true>(L + RING_OFF, gm, S, E); }
        { const float* g = ptab_in(PT, 2) + (size_t)li * 6 * D;
          FUSED_GEMM(((li & 1) ? WS_PB2 : WS_PB), WS_WP + (li & 1) * WS_WALT, PLE, (const bf16*)WSB(bf16, WS_Y), g + 5 * D, 2); }
        if (li + 1 < DEPTH) { convert_layer(PT, li + 1, L, gw, NGW, wave, lane); GRID_SYNC(); }
    }
#undef tid
#undef lane
#undef wave
#undef G
#undef bx
#undef vcu
#undef gw
#undef NGW
}

extern "C" void kernel_launch(void* const* d_in, const int* in_sizes, int n_in, void* d_out, int out_size, void* d_ws, size_t ws_size, hipStream_t stream) {
    static int grid = 0;
    if (grid == 0) {
        if (n_in != 13 || in_sizes[0] != M * D || out_size != M * D || ws_size < WS_END) { fprintf(stderr, "kernel_launch: unexpected shapes (n_in %d, in0 %d, out %d, ws %zu)\n", n_in, n_in > 0 ? in_sizes[0] : -1, out_size, ws_size); grid = -1; return; }
        int dev = 0, cus = 0, per_cu = 0;
        if (hipGetDevice(&dev) != hipSuccess || hipDeviceGetAttribute(&cus, hipDeviceAttributeMultiprocessorCount, dev) != hipSuccess) { grid = -1; return; }
        if (hipFuncSetAttribute((const void*)trunk_fwd, hipFuncAttributeMaxDynamicSharedMemorySize, LDS_BYTES) != hipSuccess) { fprintf(stderr, "kernel_launch: hipFuncSetAttribute failed\n"); grid = -1; return; }
        if (hipOccupancyMaxActiveBlocksPerMultiprocessor(&per_cu, (const void*)trunk_fwd, NWAVES * 64, LDS_BYTES) != hipSuccess || per_cu < 1) { fprintf(stderr, "kernel_launch: occupancy query says %d\n", per_cu); per_cu = 1; }
        (void)hipGetLastError();
        grid = cus * per_cu;
    }
    if (grid < 0) return;
    (void)hipMemsetAsync((char*)d_ws + WS_CTL, 0, CTL_ZERO_BYTES, stream);
    Args a{};
    for (int i = 0; i < 13; ++i) a.in[i] = (const float*)d_in[i];
    a.out = (float*)d_out; a.ws = (unsigned char*)d_ws;
    void* kargs[] = {&a};
    hipError_t e = hipLaunchCooperativeKernel((const void*)trunk_fwd, dim3(grid), dim3(NWAVES * 64), kargs, LDS_BYTES, stream);
    if (e != hipSuccess) fprintf(stderr, "cooperative launch failed: %s (grid %d)\n", hipGetErrorString(e), grid);
}
```

```cpp
#include <hip/hip_runtime.h>
#include <hip/hip_cooperative_groups.h>
#include <cstdio>
#include <cstdint>
namespace cg = cooperative_groups;
__device__ __forceinline__ int opq_v(int v) { asm volatile("" : "+v"(v)); return v; }
__device__ __forceinline__ int opq_s(int v) { asm volatile("" : "+s"(v)); return v; }
__device__ __forceinline__ float shflx_f(float v, int mask, int lane) { return __int_as_float(__builtin_amdgcn_ds_bpermute((lane ^ mask) << 2, __float_as_int(v))); }
__device__ __forceinline__ int shflx_i(int v, int mask, int lane) { return __builtin_amdgcn_ds_bpermute((lane ^ mask) << 2, v); }
__device__ __forceinline__ float sum_rows4(float v) {
    auto a = __builtin_amdgcn_permlane16_swap(__float_as_uint(v), __float_as_uint(v), false, false); v = __uint_as_float(a[0]) + __uint_as_float(a[1]);
    auto b = __builtin_amdgcn_permlane32_swap(__float_as_uint(v), __float_as_uint(v), false, false); return __uint_as_float(b[0]) + __uint_as_float(b[1]);
}
namespace pg8 {
#define PG8_LAS __attribute__((address_space(3)))
typedef unsigned short bf16_t;
typedef short bf16x8 __attribute__((ext_vector_type(8)));
typedef float f32x4 __attribute__((ext_vector_type(4)));
typedef unsigned u32x4 __attribute__((ext_vector_type(4)));
constexpr int BM = 256, BK = 64, HALF = 128, HTB = HALF * BK * 2  , STAGE_BYTES = 8 * HTB, NXCD = 8, WGM = 8;

__host__ __device__ __forceinline__ int lds_byte(int r, int c) { const int st = (r >> 4) * 2 + (c >> 5), rr = r & 15, cc = c & 31, ob = rr * 64 + cc * 2; return st * 1024 + (ob ^ (((ob >> 9) & 1) << 5)); }
__host__ __device__ __forceinline__ void stage_rc(int b, int& R, int& C) { const int st = b / 1024, sb = b % 1024, swz = sb ^ (((sb >> 9) & 1) << 5); R = (st >> 1) * 16 + swz / 64; C = (st & 1) * 32 + (swz % 64) / 2; }
__host__ __device__ __forceinline__ int perm32(int rho) { const int n = rho >> 4, i = rho & 15; return 8 * (i >> 2) + 4 * n + (i & 3); }

struct Unit { int pm, pn; };
struct Gemm { const bf16_t* A; const bf16_t* Bt; int M, N, K; };

struct StaticOrder {
    int nM, nN, nwg, G, c;
    __host__ __device__ void init(int M, int N, int G_, int c_) { nM = M / BM; nN = N / BM; nwg = nM * nN; G = G_; c = c_; }
    __host__ __device__ bool next(int i, Unit& u) const {
        const long L = (long)i * G + c; if (L >= nwg) return false;
        int wgid = (int)L; { const int q = nwg / NXCD, r = nwg % NXCD, xcd = wgid % NXCD, off = wgid / NXCD; wgid = (xcd < r ? xcd * (q + 1) : r * (q + 1) + (xcd - r) * q) + off; }
        const int nig = WGM * nN, gid = wgid / nig, fm = gid * WGM, gsz = (nM - fm) < WGM ? (nM - fm) : WGM;
        u.pm = fm + ((wgid % nig) % gsz); u.pn = (wgid % nig) / gsz; return true;
    }
    __device__ __forceinline__ void a_ready(const Unit&) const {}
    __device__ __forceinline__ void done(const Unit&) const {}
};

__device__ __forceinline__ unsigned cvt_pk_bf16(float lo, float hi) { unsigned r; asm volatile("v_cvt_pk_bf16_f32 %0, %1, %2" : "=v"(r) : "v"(lo), "v"(hi)); return r; }
typedef float f32x2 __attribute__((ext_vector_type(2)));
typedef float f32x2 __attribute__((ext_vector_type(2)));
template <int ACT  > struct EpiBf16 {
    static constexpr bool PERM = true, AFTER_DRAIN = false, ADJ = true;
    bf16_t* O; int ldc; int split_cols; size_t split_stride; float scale0; float* flog; const float* rs; unsigned* qkm;
    __device__ __forceinline__ void operator()(const f32x4 (&acc)[2][2][4][2], const Unit& u, int wr, int wc, int fr, int fq) const {
        const int row0 = u.pm * BM + wr * 64 + fr; int colt = u.pn * BM; bf16_t* base = O;
        float sc = 1.f; int t = 0;
        if (split_cols) { t = colt / split_cols; base += (size_t)t * split_stride; colt -= t * split_cols; if (t == 0) sc = scale0; }
        if (t == 3) {
            if (wc == 0 && fq < 2) {
#pragma unroll
                for (int ai = 0; ai < 2; ++ai)
#pragma unroll
                    for (int m = 0; m < 4; ++m) { float* rp = flog + (size_t)(row0 + ai * HALF + m * 16) * 16 + 8 * fq; *(f32x4*)rp = acc[ai][0][m][0]; *(f32x4*)(rp + 4) = acc[ai][0][m][1]; }
            }
            return;
        }
        const int col0 = colt + wc * 64 + 8 * fq; const int lane_ = fq * 16 + fr;
        const bool trk = ACT == 0 && qkm != nullptr && t < 2; float cm0 = 0.f, cm1 = 0.f;
        if (ACT == 4 && t >= 1) {
            bf16_t* zb = O + split_stride + (size_t)row0 * ldc + (u.pn - 4) * 128 + wc * 32 + fq * 8;
#pragma unroll
            for (int ai = 0; ai < 2; ++ai)
#pragma unroll
                for (int m = 0; m < 4; ++m) { const float r2 = rs[row0 + ai * HALF + m * 16]; const float rr = r2 * r2;
                    const f32x4 z0 = acc[ai][0][m][0] * acc[ai][0][m][1] * rr, z1 = acc[ai][1][m][0] * acc[ai][1][m][1] * rr;
                    u32x4 w; w.x = cvt_pk_bf16(z0[0], z0[1]); w.y = cvt_pk_bf16(z0[2], z0[3]); w.z = cvt_pk_bf16(z1[0], z1[1]); w.w = cvt_pk_bf16(z1[2], z1[3]);
                    *(u32x4*)(zb + (size_t)(ai * HALF + m * 16) * ldc) = w; }
            return;
        }
        float rsv[2][4];
#pragma unroll
        for (int ai = 0; ai < 2; ++ai)
#pragma unroll
            for (int m = 0; m < 4; ++m) rsv[ai][m] = rs[row0 + ai * HALF + m * 16];
#pragma unroll
        for (int ai = 0; ai < 2; ++ai)
#pragma unroll
            for (int m = 0; m < 4; ++m) { bf16_t* rowp = base + (size_t)(row0 + ai * HALF + m * 16) * ldc + col0;
#pragma unroll
                for (int bj = 0; bj < 2; ++bj) { f32x4 v0 = acc[ai][bj][m][0] * rsv[ai][m], v1 = acc[ai][bj][m][1] * rsv[ai][m];
                    if (ACT == 3) {
#pragma unroll
                        for (int i = 0; i < 4; ++i) { v0[i] = 1.f / (1.f + __expf(-v0[i])); v1[i] = 1.f / (1.f + __expf(-v1[i])); } }
                    if (ACT == 2) {
#pragma unroll
                        for (int i = 0; i < 4; ++i) { const float a = fmaxf(v0[i], 0.f), b = fmaxf(v1[i], 0.f); v0[i] = a * a; v1[i] = b * b; } }
                    v0 = v0 * sc; v1 = v1 * sc; u32x4 w; w.x = cvt_pk_bf16(v0[0], v0[1]); w.y = cvt_pk_bf16(v0[2], v0[3]); w.z = cvt_pk_bf16(v1[0], v1[1]); w.w = cvt_pk_bf16(v1[2], v1[3]);
                    *(u32x4*)(rowp + bj * 32) = w;
                    if (trk) { float q = ((v0[0] * v0[0] + v0[1] * v0[1]) + (v0[2] * v0[2] + v0[3] * v0[3])) + ((v1[0] * v1[0] + v1[1] * v1[1]) + (v1[2] * v1[2] + v1[3] * v1[3]));
                        q = sum_rows4(q);
                        if (bj == 0) cm0 = fmaxf(cm0, q); else cm1 = fmaxf(cm1, q); } } }
        if (trk) {
#pragma unroll
            for (int o = 1; o < 16; o <<= 1) { cm0 = fmaxf(cm0, shflx_f(cm0, o, lane_)); cm1 = fmaxf(cm1, shflx_f(cm1, o, lane_)); }
            if (lane_ == 0) { const int b = (u.pm * BM) >> 14, hd = (colt >> 6) + wc;
                __hip_atomic_fetch_max(qkm + ((b * 16 + hd) * 2 + t) * 2 + 0, __float_as_uint(cm0), __ATOMIC_RELAXED, __HIP_MEMORY_SCOPE_AGENT);
                __hip_atomic_fetch_max(qkm + ((b * 16 + hd) * 2 + t) * 2 + 1, __float_as_uint(cm1), __ATOMIC_RELAXED, __HIP_MEMORY_SCOPE_AGENT); }
        }
    }
};
struct PanelRms {
    unsigned* xbuf;
    unsigned* cnt;
    unsigned* tmo;
    unsigned want; float eps; float* rsout;
    __device__ __forceinline__ void run(const f32x4 (&v)[2][2][4][2], const Unit& u, int wr, int wc, int fr, int fq, PG8_LAS unsigned char* lds, int wid, int lane) const {
        PG8_LAS float* P = (PG8_LAS float*)lds;
        PG8_LAS float* S = (PG8_LAS float*)(lds + 8192);
#pragma unroll
        for (int ai = 0; ai < 2; ++ai)
#pragma unroll
            for (int m = 0; m < 4; ++m) {
                float q = 0.f;
#pragma unroll
                for (int bj = 0; bj < 2; ++bj)
#pragma unroll
                    for (int n = 0; n < 2; ++n) { const f32x4 x = v[ai][bj][m][n]; q += (x[0] * x[0] + x[1] * x[1]) + (x[2] * x[2] + x[3] * x[3]); }
                q = sum_rows4(q);
                if (fq == 0) P[(ai * HALF + wr * 64 + m * 16 + fr) * 4 + wc] = q;
            }
        asm volatile("s_waitcnt lgkmcnt(0)" ::: "memory"); __builtin_amdgcn_s_barrier(); asm volatile("" ::: "memory");
        const int row = wid * 32 + (lane & 31);
        if (lane < 32) {
            const f32x4 p = *(const PG8_LAS f32x4*)(P + row * 4);
            __hip_atomic_store(xbuf + ((size_t)(u.pm * BM + row) * 4 + u.pn), __float_as_uint((p[0] + p[1]) + (p[2] + p[3])), __ATOMIC_RELAXED, __HIP_MEMORY_SCOPE_AGENT);
        }
        asm volatile("s_waitcnt vmcnt(0)" ::: "memory");
        if (lane == 0) __hip_atomic_fetch_add(cnt + 64 * u.pm, 1u, __ATOMIC_RELAXED, __HIP_MEMORY_SCOPE_AGENT);
        if (wid == 0) {
            for (int sp = 0;; ++sp) {
                if ((unsigned)__builtin_amdgcn_readfirstlane(__hip_atomic_load(cnt + 64 * u.pm, __ATOMIC_RELAXED, __HIP_MEMORY_SCOPE_AGENT)) >= want) break;
                if (sp > 65536) { if (lane == 0) __hip_atomic_store(tmo, 1u, __ATOMIC_RELAXED, __HIP_MEMORY_SCOPE_AGENT); break; }
                __builtin_amdgcn_s_sleep(2);
            }
        }
        asm volatile("s_waitcnt vmcnt(0) lgkmcnt(0)" ::: "memory"); __builtin_amdgcn_s_barrier(); asm volatile("" ::: "memory");
        if (lane < 32) {
            const unsigned* slot = xbuf + (size_t)(u.pm * BM + row) * 4; float q = 0.f;
#pragma unroll
            for (int t = 0; t < 4; ++t) q += __uint_as_float(__hip_atomic_load(slot + t, __ATOMIC_RELAXED, __HIP_MEMORY_SCOPE_AGENT));
            const float rstd_ = 1.0f / sqrtf(q * (1.0f / 1024.0f) + eps); S[row] = rstd_;
            if (rsout && u.pn == 0) rsout[u.pm * BM + row] = rstd_;
        }
        asm volatile("s_waitcnt lgkmcnt(0)" ::: "memory"); __builtin_amdgcn_s_barrier(); asm volatile("" ::: "memory");
    }
};
struct EpiRms {
    static constexpr bool PERM = true, AFTER_DRAIN = true, ADJ = false;
    const void* base; void* out; const bf16_t* mul; const float* gA; int ldc; PanelRms st1, st2; int base_f32, out_f32, need_rs;
    __device__ __forceinline__ void fused(f32x4 (&acc)[2][2][4][2], const Unit& u, int wr, int wc, int fr, int fq, PG8_LAS unsigned char* lds, int wid, int lane) const {
        typedef unsigned u32x2v __attribute__((ext_vector_type(2)));
        const PG8_LAS float* S = (const PG8_LAS float*)(lds + 8192);
        const int col0 = u.pn * BM + wc * 32 + 8 * fq;
        const unsigned b0 = (unsigned)((u.pm * BM + wr * 64 + fr) * ldc + col0) * 4u;
#define RMS_OFF(ai, m, bj, n) (b0 + (unsigned)(((ai) * HALF + (m) * 16) * ldc + (bj) * HALF + (n) * 4) * 4u)
#define RMS_UNPK(PK_, lo, hi) do { lo = (f32x4){__uint_as_float((PK_)[0] << 16), __uint_as_float((PK_)[0] & 0xffff0000u), __uint_as_float((PK_)[1] << 16), __uint_as_float((PK_)[1] & 0xffff0000u)}; \
                                   hi = (f32x4){__uint_as_float((PK_)[2] << 16), __uint_as_float((PK_)[2] & 0xffff0000u), __uint_as_float((PK_)[3] << 16), __uint_as_float((PK_)[3] & 0xffff0000u)}; } while (0)
#define RMS_LOADX(ai, m, bj, lo, hi) do { if (base_f32) { lo = *(const f32x4*)((const char*)base + RMS_OFF(ai, m, bj, 0)); hi = *(const f32x4*)((const char*)base + RMS_OFF(ai, m, bj, 1)); } \
                                          else { const u32x4 w_ = *(const u32x4*)((const char*)base + (RMS_OFF(ai, m, bj, 0) >> 1)); RMS_UNPK(w_, lo, hi); } } while (0)
#define RMS_STOREX(ai, m, bj, lo, hi) do { if (out_f32) { *(f32x4*)((char*)out + RMS_OFF(ai, m, bj, 0)) = lo; *(f32x4*)((char*)out + RMS_OFF(ai, m, bj, 1)) = hi; } \
                                           else { u32x4 w_; w_.x = cvt_pk_bf16(lo[0], lo[1]); w_.y = cvt_pk_bf16(lo[2], lo[3]); w_.z = cvt_pk_bf16(hi[0], hi[1]); w_.w = cvt_pk_bf16(hi[2], hi[3]); \
                                                  *(u32x4*)((char*)out + (RMS_OFF(ai, m, bj, 0) >> 1)) = w_; } } while (0)
        if (mul) {
#pragma unroll
            for (int ai = 0; ai < 2; ++ai)
#pragma unroll
                for (int m = 0; m < 4; ++m) {
#pragma unroll
                    for (int bj = 0; bj < 2; ++bj) { const u32x4 w = *(const u32x4*)((const char*)mul + (RMS_OFF(ai, m, bj, 0) >> 1)); f32x4 lo, hi; RMS_UNPK(w, lo, hi);
                        acc[ai][bj][m][0] = acc[ai][bj][m][0] * lo; acc[ai][bj][m][1] = acc[ai][bj][m][1] * hi; }
                    asm volatile("" : "+v"(acc[ai][0][m][0]), "+v"(acc[ai][0][m][1]), "+v"(acc[ai][1][m][0]), "+v"(acc[ai][1][m][1]));
                    if (m & 1) asm volatile("" ::: "memory"); }
        }
        f32x4 pre[2][2][2];
#pragma unroll
        for (int m = 0; m < 2; ++m)
#pragma unroll
            for (int bj = 0; bj < 2; ++bj) RMS_LOADX(0, m, bj, pre[m][bj][0], pre[m][bj][1]);
        f32x4 gpre[2][2];
#pragma unroll
        for (int bj = 0; bj < 2; ++bj)
#pragma unroll
            for (int n = 0; n < 2; ++n) gpre[bj][n] = *(const f32x4*)(gA + col0 + bj * HALF + n * 4);
        st1.run(acc, u, wr, wc, fr, fq, lds, wid, lane);
#pragma unroll
        for (int bj = 0; bj < 2; ++bj)
#pragma unroll
            for (int n = 0; n < 2; ++n) { const f32x4 g = gpre[bj][n];
#pragma unroll
                for (int ai = 0; ai < 2; ++ai)
#pragma unroll
                    for (int m = 0; m < 4; ++m) acc[ai][bj][m][n] = acc[ai][bj][m][n] * g; }
#pragma unroll
        for (int ai = 0; ai < 2; ++ai)
#pragma unroll
            for (int m = 0; m < 4; ++m) { const float sr = S[ai * HALF + wr * 64 + m * 16 + fr];
#pragma unroll
                for (int bj = 0; bj < 2; ++bj) { f32x4 lo, hi;
                    if (ai == 0 && m < 2) { lo = pre[m & 1][bj][0]; hi = pre[m & 1][bj][1]; } else RMS_LOADX(ai, m, bj, lo, hi);
                    acc[ai][bj][m][0] = lo + acc[ai][bj][m][0] * sr; acc[ai][bj][m][1] = hi + acc[ai][bj][m][1] * sr;
                    RMS_STOREX(ai, m, bj, acc[ai][bj][m][0], acc[ai][bj][m][1]); }
                asm volatile("" : "+v"(acc[ai][0][m][0]), "+v"(acc[ai][0][m][1]), "+v"(acc[ai][1][m][0]), "+v"(acc[ai][1][m][1]));
                asm volatile("" ::: "memory"); }
        if (need_rs) st2.run(acc, u, wr, wc, fr, fq, lds, wid, lane);
        asm volatile("s_waitcnt lgkmcnt(0)" ::: "memory"); __builtin_amdgcn_s_barrier(); asm volatile("" ::: "memory");
#undef RMS_OFF
#undef RMS_UNPK
#undef RMS_LOADX
#undef RMS_STOREX
    }
};
struct RoundOrder {
    StaticOrder b; int round;
    __device__ __forceinline__ bool next(int i, Unit& u) const { return i == 0 && b.next(round, u); }
    __device__ __forceinline__ void a_ready(const Unit&) const {}
    __device__ __forceinline__ void done(const Unit&) const {}
};

template <class Epi, class Sched, bool ALIGN_EPI = false, bool SP2 = false>
__device__ __forceinline__ void gemm_phase(PG8_LAS unsigned char* lds, const Gemm g, const Sched& S, const Epi& E) {
    const int tid = opq_v((int)threadIdx.x), wid = __builtin_amdgcn_readfirstlane(tid >> 6), lane = tid & 63, wr = wid >> 2, wc = wid & 3, fr = lane & 15, fq = lane >> 4;
    const int K = g.K, nt = K / BK;
    unsigned voffA[2], voffB[2];
#pragma unroll
    for (int i = 0; i < 2; ++i) { int R, C; stage_rc(tid * 16 + i * 8192, R, C); const int Rb = Epi::ADJ ? (64 * (R >> 5) + perm32(R & 31)) : Epi::PERM ? ((R & ~31) + perm32(R & 31)) : R;
        voffA[i] = (unsigned)(R * K + C) * 2u; voffB[i] = (unsigned)(Rb * K + C) * 2u; }
    const size_t kstep = (size_t)(BK * 2);
    const size_t hstep = (size_t)HALF * K * 2;
    const size_t tstep = 2 * hstep;
    const size_t bhstep = Epi::ADJ ? (size_t)32 * K * 2 : hstep;
    const unsigned ldsw = (unsigned)wid * 1024u;
    const int aoff = lds_byte(wr * 64 + fr, fq * 8), boff = lds_byte(wc * 32 + fr, fq * 8);
#define PG8_SA(b, h) (((b) * 2 + (h)) * HTB)
#define PG8_SB(b, h) ((4 + (b) * 2 + (h)) * HTB)
#define PG8_STAGE(bufoff, gbase, voff) do { _Pragma("unroll") for (int _i = 0; _i < 2; ++_i) \
        __builtin_amdgcn_global_load_lds((const unsigned*)((const char*)(gbase) + (voff)[_i]), (PG8_LAS unsigned*)(lds + (bufoff) + ldsw + _i * 8192), 16, 0, 0); } while (0)
#define PG8_LDA(dst, b, h) do { _Pragma("unroll") for (int m = 0; m < 4; ++m) _Pragma("unroll") for (int k = 0; k < 2; ++k) dst[m][k] = *(const PG8_LAS bf16x8*)(lds + PG8_SA(b, h) + aoff + m * 2048 + k * 1024); } while (0)
#define PG8_LDB(dst, b, h) do { _Pragma("unroll") for (int n = 0; n < 2; ++n) _Pragma("unroll") for (int k = 0; k < 2; ++k) dst[n][k] = *(const PG8_LAS bf16x8*)(lds + PG8_SB(b, h) + boff + n * 2048 + k * 1024); } while (0)
#define PG8_MMA(ai, bj, At, Bt) do { __builtin_amdgcn_s_setprio(1); _Pragma("unroll") for (int m = 0; m < 4; ++m) _Pragma("unroll") for (int n = 0; n < 2; ++n) _Pragma("unroll") for (int k = 0; k < 2; ++k) \
        acc[ai][bj][m][n] = __builtin_amdgcn_mfma_f32_16x16x32_bf16(Bt[n][k], At[m][k], acc[ai][bj][m][n], 0, 0, 0); __builtin_amdgcn_s_setprio(0); } while (0)
#define PG8_WAIT_V(n) asm volatile("s_waitcnt vmcnt(" #n ")" ::: "memory")
#define PG8_WAIT_L(n) asm volatile("s_waitcnt lgkmcnt(" #n ")" ::: "memory")
#define PG8_BAR __builtin_amdgcn_s_barrier()
#define PG8_SCHED __builtin_amdgcn_sched_barrier(0)
    Unit cur, nxt; int ui = 0;
    if (!S.next(0, cur)) return;
    f32x4 acc[2][2][4][2];
#pragma unroll
    for (int a = 0; a < 2; ++a)
#pragma unroll
        for (int b = 0; b < 2; ++b)
#pragma unroll
            for (int m = 0; m < 4; ++m)
#pragma unroll
                for (int n = 0; n < 2; ++n) acc[a][b][m][n] = (f32x4){0.f, 0.f, 0.f, 0.f};
    bf16x8 At[4][2], B0[2][2], B1[2][2];
    const char* cA = (const char*)g.A + (size_t)cur.pm * tstep; const char* cB = (const char*)g.Bt + (size_t)cur.pn * tstep;
    S.a_ready(cur);
    if constexpr (SP2) {
        PG8_STAGE(PG8_SB(0, 0), cB, voffB); PG8_STAGE(PG8_SB(0, 1), cB + bhstep, voffB); PG8_STAGE(PG8_SA(0, 0), cA, voffA); PG8_STAGE(PG8_SA(0, 1), cA + hstep, voffA);
        if (wr == 1) PG8_BAR;
        PG8_WAIT_V(2); PG8_BAR;
        PG8_STAGE(PG8_SB(1, 0), cB + kstep, voffB); PG8_STAGE(PG8_SA(1, 0), cA + kstep, voffA); PG8_STAGE(PG8_SB(1, 1), cB + bhstep + kstep, voffB);
        PG8_WAIT_V(6); PG8_BAR;
    } else {
        PG8_STAGE(PG8_SB(0, 0), cB, voffB); PG8_STAGE(PG8_SA(0, 0), cA, voffA); PG8_STAGE(PG8_SB(0, 1), cB + bhstep, voffB); PG8_STAGE(PG8_SA(0, 1), cA + hstep, voffA);
        if (wr == 1) PG8_BAR;
        PG8_WAIT_V(4); PG8_BAR;
        PG8_STAGE(PG8_SB(1, 0), cB + kstep, voffB); PG8_STAGE(PG8_SA(1, 0), cA + kstep, voffA); PG8_STAGE(PG8_SB(1, 1), cB + bhstep + kstep, voffB);
        PG8_WAIT_V(6); PG8_BAR;
    }
    for (;;) {
        const bool has_next = S.next(ui + 1, nxt);
        const char* nA = has_next ? (const char*)g.A + (size_t)nxt.pm * tstep : cA; const char* nB = has_next ? (const char*)g.Bt + (size_t)nxt.pn * tstep : cB;
        for (int t = 0; t < nt; t += 2) {
            const bool last = (t == nt - 2);
            const char* a1 = cA + (size_t)(t + 1) * kstep;
            const char* a2 = last ? nA : cA + (size_t)(t + 2) * kstep; const char* b2 = last ? nB : cB + (size_t)(t + 2) * kstep;
            const char* a3 = a2 + kstep; const char* b3 = b2 + kstep;
            if (last && has_next) S.a_ready(nxt);
            if constexpr (SP2) {
            PG8_LDB(B0, 0, 0); PG8_LDB(B1, 0, 1); PG8_SCHED; PG8_LDA(At, 0, 0); PG8_STAGE(PG8_SA(1, 1), a1 + hstep, voffA);
            PG8_WAIT_V(8); PG8_WAIT_L(0); PG8_BAR; PG8_MMA(0, 0, At, B0); PG8_MMA(0, 1, At, B1); PG8_BAR; PG8_SCHED;
            PG8_LDA(At, 0, 1); PG8_STAGE(PG8_SB(0, 0), b2, voffB); PG8_STAGE(PG8_SB(0, 1), b2 + bhstep, voffB); PG8_STAGE(PG8_SA(0, 0), a2, voffA);
            PG8_WAIT_V(8); PG8_WAIT_L(0); PG8_BAR; PG8_MMA(1, 0, At, B0); PG8_MMA(1, 1, At, B1); PG8_BAR; PG8_SCHED;
            PG8_LDB(B0, 1, 0); PG8_LDB(B1, 1, 1); PG8_SCHED; PG8_LDA(At, 1, 0); PG8_STAGE(PG8_SA(0, 1), a2 + hstep, voffA);
            PG8_WAIT_V(8); PG8_WAIT_L(0); PG8_BAR; PG8_MMA(0, 0, At, B0); PG8_MMA(0, 1, At, B1); PG8_BAR; PG8_SCHED;
            PG8_LDA(At, 1, 1); PG8_STAGE(PG8_SB(1, 0), b3, voffB); PG8_STAGE(PG8_SB(1, 1), b3 + bhstep, voffB); PG8_STAGE(PG8_SA(1, 0), a3, voffA);
            PG8_WAIT_V(8); PG8_WAIT_L(0); PG8_BAR; PG8_MMA(1, 0, At, B0); PG8_MMA(1, 1, At, B1); PG8_BAR; PG8_SCHED;
            } else {
            PG8_LDB(B0, 0, 0); PG8_SCHED; PG8_LDA(At, 0, 0); PG8_STAGE(PG8_SA(1, 1), a1 + hstep, voffA);
            PG8_WAIT_L(8); PG8_BAR; PG8_WAIT_L(0); PG8_MMA(0, 0, At, B0); PG8_BAR; PG8_SCHED;
            PG8_LDB(B1, 0, 1); PG8_STAGE(PG8_SB(0, 0), b2, voffB);
            PG8_BAR; PG8_WAIT_L(0); PG8_MMA(0, 1, At, B1); PG8_BAR;
            PG8_LDA(At, 0, 1); PG8_STAGE(PG8_SA(0, 0), a2, voffA);
            PG8_BAR; PG8_WAIT_L(0); PG8_MMA(1, 0, At, B0); PG8_BAR; PG8_SCHED;
            PG8_STAGE(PG8_SB(0, 1), b2 + bhstep, voffB);
            PG8_WAIT_V(6); PG8_BAR; PG8_MMA(1, 1, At, B1); PG8_BAR;
            PG8_LDB(B0, 1, 0); PG8_SCHED; PG8_LDA(At, 1, 0); PG8_STAGE(PG8_SA(0, 1), a2 + hstep, voffA);
            PG8_WAIT_L(8); PG8_BAR; PG8_WAIT_L(0); PG8_MMA(0, 0, At, B0); PG8_BAR; PG8_SCHED;
            PG8_LDB(B1, 1, 1); PG8_STAGE(PG8_SB(1, 0), b3, voffB);
            PG8_BAR; PG8_WAIT_L(0); PG8_MMA(0, 1, At, B1); PG8_BAR;
            PG8_LDA(At, 1, 1); PG8_STAGE(PG8_SA(1, 0), a3, voffA);
            PG8_BAR; PG8_WAIT_L(0); PG8_MMA(1, 0, At, B0); PG8_BAR; PG8_SCHED;
            PG8_STAGE(PG8_SB(1, 1), b3 + bhstep, voffB);
            PG8_WAIT_V(6); PG8_BAR; PG8_MMA(1, 1, At, B1); PG8_BAR;
            }
        }
        if constexpr (ALIGN_EPI) { if (wr == 0) PG8_BAR; }
        if constexpr (!Epi::AFTER_DRAIN) { E(acc, cur, wr, wc, fr, fq); S.done(cur); }
        if (!has_next) break;
#pragma unroll
        for (int a = 0; a < 2; ++a)
#pragma unroll
            for (int b = 0; b < 2; ++b)
#pragma unroll
                for (int m = 0; m < 4; ++m)
#pragma unroll
                    for (int n = 0; n < 2; ++n) acc[a][b][m][n] = (f32x4){0.f, 0.f, 0.f, 0.f};
        cur = nxt; cA = nA; cB = nB; ++ui;
        if constexpr (ALIGN_EPI) { if (wr == 1) PG8_BAR; }
    }
    PG8_WAIT_V(0);
    if constexpr (!ALIGN_EPI) { if (wr == 0) PG8_BAR; }
    PG8_BAR;
    if constexpr (Epi::AFTER_DRAIN) { E.fused(acc, cur, wr, wc, fr, fq, lds, wid, lane); S.done(cur); }
#undef PG8_SA
#undef PG8_SB
#undef PG8_STAGE
#undef PG8_LDA
#undef PG8_LDB
#undef PG8_MMA
#undef PG8_WAIT_V
#undef PG8_WAIT_L
#undef PG8_BAR
#undef PG8_SCHED
}
}
#include <hip/hip_bf16.h>
#include <cmath>
namespace attn_body {
using bf16=__hip_bfloat16;
using bf16x8=__attribute__((ext_vector_type(8)))short;
using s16x4=__attribute__((ext_vector_type(4)))short;
using f32x16=__attribute__((ext_vector_type(16)))float;
using u32x4=__attribute__((ext_vector_type(4)))unsigned;
constexpr int BATCH=2,NHEAD=16,SEQ=16384,D=64,DM=NHEAD*D;
constexpr int NW=8,QBLK=32,QB=QBLK*NW,KVBLK=64,NQB=SEQ/QB;
constexpr int ATTN_PITCH=DM, ATTN_UNIT_ROWS=QB;
__device__ __forceinline__ int crow(int r,int hi){return (r&3)+8*(r>>2)+4*hi;}
#define SBAR() __builtin_amdgcn_sched_barrier(0)
__device__ __forceinline__ void cmask(f32x16&p0,f32x16&p1,int jb,int qrel,int hi){
  const float NEG=__int_as_float(opq_s((int)0xff800000)); int kb=64*jb+4*hi;
  #pragma unroll
  for(int r=0;r<16;++r){int kv=kb+(r&3)+8*(r>>2); if(kv>qrel)p0[r]=NEG; if(kv+32>qrel)p1[r]=NEG;}
}

constexpr int NSLOT=3, SLOTB=8192;
constexpr int LDS_K=0, LDS_V=NSLOT*SLOTB, LDS_WS=2*NSLOT*SLOTB, LDS_CK=LDS_WS+NW*64*4, LDS_OST=LDS_CK, LDS_BYTES=LDS_CK+65536;
constexpr float C2=0.125f*1.4426950408889634f;
__device__ __forceinline__ void glds16(const void*gsrc,unsigned lds_dst){unsigned keep;
  asm volatile("s_mov_b32 %0, m0\n\ts_mov_b32 m0, %2\n\ts_nop 0\n\tglobal_load_lds_dwordx4 %1, off\n\ts_mov_b32 m0, %0":"=&s"(keep):"v"(gsrc),"s"(lds_dst):"memory");}
__device__ __forceinline__ float max3f(float a,float b,float c){float r;asm("v_max3_f32 %0, %1, %2, %3":"=v"(r):"v"(a),"v"(b),"v"(c));return r;}
__device__ __forceinline__ float max2f(float a,float b){float r;asm("v_max_f32_e32 %0, %1, %2":"=v"(r):"v"(a),"v"(b));return r;}
__device__ __forceinline__ float fadd_s(float a,float b){float r;asm("v_add_f32_e32 %0, %1, %2":"=v"(r):"v"(a),"v"(b));return r;}
__device__ __forceinline__ float fsub_s(float a,float b){float r;asm("v_sub_f32_e32 %0, %1, %2":"=v"(r):"v"(a),"v"(b));return r;}
typedef float f32x2_t __attribute__((ext_vector_type(2))); typedef __bf16 bf16x2_t __attribute__((ext_vector_type(2)));
__device__ __forceinline__ unsigned cvtpk_s(float lo,float hi){f32x2_t v={lo,hi};bf16x2_t b=__builtin_convertvector(v,bf16x2_t);return __builtin_bit_cast(unsigned,b);}
#define WAIT_BAR(N) asm volatile("s_waitcnt vmcnt(" #N ") lgkmcnt(0)\n\ts_barrier":::"memory")

__device__ __forceinline__ void qkt(f32x16&p0,f32x16&p1,const char*Kslot,const bf16x8*qr,const f32x16&negm,int r32,int hi){
  const char*kb=Kslot+hi*1024+r32*16;
  #pragma unroll
  for(int d0=0;d0<4;++d0){
    const bf16x8 b0=*reinterpret_cast<const bf16x8*>(kb+d0*2048);
    const bf16x8 b1=*reinterpret_cast<const bf16x8*>(kb+d0*2048+512);
    if(d0==0){p0=__builtin_amdgcn_mfma_f32_32x32x16_bf16(b0,qr[0],negm,0,0,0);p1=__builtin_amdgcn_mfma_f32_32x32x16_bf16(b1,qr[0],negm,0,0,0);}
    else{p0=__builtin_amdgcn_mfma_f32_32x32x16_bf16(b0,qr[d0],p0,0,0,0);p1=__builtin_amdgcn_mfma_f32_32x32x16_bf16(b1,qr[d0],p1,0,0,0);}}
}
typedef __attribute__((address_space(3))) const char* lds_cptr;
typedef short v4i16_t __attribute__((ext_vector_type(4)));
__device__ __forceinline__ void kload8(bf16x8*kf,lds_cptr kp){
  kf[0]=*(const __attribute__((address_space(3))) bf16x8*)(kp);      kf[1]=*(const __attribute__((address_space(3))) bf16x8*)(kp+512);
  kf[2]=*(const __attribute__((address_space(3))) bf16x8*)(kp+2048); kf[3]=*(const __attribute__((address_space(3))) bf16x8*)(kp+2560);
  kf[4]=*(const __attribute__((address_space(3))) bf16x8*)(kp+4096); kf[5]=*(const __attribute__((address_space(3))) bf16x8*)(kp+4608);
  kf[6]=*(const __attribute__((address_space(3))) bf16x8*)(kp+6144); kf[7]=*(const __attribute__((address_space(3))) bf16x8*)(kp+6656);
}
__device__ __forceinline__ void kload2(bf16x8*kf,lds_cptr kp,int j){ kf[2*j]=*(const __attribute__((address_space(3))) bf16x8*)(kp+j*2048); kf[2*j+1]=*(const __attribute__((address_space(3))) bf16x8*)(kp+j*2048+512); }
__device__ __forceinline__ s16x4 vtr(lds_cptr p){ return __builtin_bit_cast(s16x4,__builtin_amdgcn_ds_read_tr16_b64_v4i16((__attribute__((address_space(3))) v4i16_t*)p)); }
__device__ __forceinline__ float rowmax(const f32x16&p0,const f32x16&p1){
  float a=max3f(p0[0],p0[1],p1[0]),b=max3f(p0[2],p0[3],p1[1]);a=max3f(a,p1[2],p1[3]);
  #pragma unroll
  for(int r=4;r<16;r+=4){a=max3f(a,p0[r],p0[r+1]);b=max3f(b,p0[r+2],p0[r+3]);a=max3f(a,p1[r],p1[r+1]);b=max3f(b,p1[r+2],p1[r+3]);}
  const float m=max2f(a,b);
  auto rr=__builtin_amdgcn_permlane32_swap(__float_as_uint(m),__float_as_uint(m),false,false);
  return max2f(__uint_as_float(rr[0]),__uint_as_float(rr[1]));
}
__device__ __forceinline__ void pv(f32x16*o,int vb,bf16x8 pa0,bf16x8 pa1,bf16x8 pa2,bf16x8 pa3){
  #pragma unroll
  for(int d0=0;d0<2;++d0){s16x4 lo[4],hi[4];
    #pragma unroll
    for(int ks=0;ks<4;++ks){
      asm volatile("ds_read_b64_tr_b16 %0,%1 offset:%c2":"=&v"(lo[ks]):"v"(vb),"i"(d0*4096+ks*1024):"memory");
      asm volatile("ds_read_b64_tr_b16 %0,%1 offset:%c2":"=&v"(hi[ks]):"v"(vb),"i"(d0*4096+ks*1024+512):"memory");}
    asm volatile("s_waitcnt lgkmcnt(0)":::"memory");SBAR();
    #define PK(k) (bf16x8){lo[k][0],lo[k][1],lo[k][2],lo[k][3],hi[k][0],hi[k][1],hi[k][2],hi[k][3]}
    o[d0]=__builtin_amdgcn_mfma_f32_32x32x16_bf16(pa0,PK(0),o[d0],0,0,0);
    o[d0]=__builtin_amdgcn_mfma_f32_32x32x16_bf16(pa1,PK(1),o[d0],0,0,0);
    o[d0]=__builtin_amdgcn_mfma_f32_32x32x16_bf16(pa2,PK(2),o[d0],0,0,0);
    o[d0]=__builtin_amdgcn_mfma_f32_32x32x16_bf16(pa3,PK(3),o[d0],0,0,0);
    #undef PK
  }
}
constexpr float SKIP_T=40.f;
#ifndef ATTN_STORE16
#define ATTN_STORE16(p,v) (*(u32x4*)(p)=(v))
#endif
typedef float f32x4a __attribute__((ext_vector_type(4)));
__device__ __forceinline__ void fox_unit(int b,int h,int qb,const bf16*Q,const bf16*__restrict__ K,const bf16*__restrict__ V,bf16*O,const float*__restrict__ c2h,float bnd,char*shm){
  const int tid=opq_v((int)threadIdx.x),lane=tid&63,r32=lane&31,hi=lane>>5; const int wid=__builtin_amdgcn_readfirstlane(tid>>6);
  const long rowbase=(long)b*SEQ; const int q0=qb*QB;
  const bf16*Qw=Q+(rowbase+q0+wid*QBLK)*DM+h*D;
  const bf16*Kh=K+rowbase*DM+h*D,*Vh=V+rowbase*DM+h*D;
  const unsigned lds0=(unsigned)(uintptr_t)shm;
  float*wsf=(float*)(shm+LDS_WS)+wid*64;
  float*CK=(float*)(shm+LDS_CK);
  const bf16*ksrc=Kh+(long)lane*DM+wid*8;
  const bf16*vsrc=Vh+(long)(16*(wid&3)+(lane>>2))*DM+(wid>>2)*32+(lane&3)*8;
  const unsigned kdst=lds0+LDS_K+wid*1024, vdst=lds0+LDS_V+wid*1024;
  #define DMA_K(t,slot) glds16(ksrc+(long)(t)*KVBLK*DM,(unsigned)__builtin_amdgcn_readfirstlane(kdst+(slot)))
  #define DMA_V(t,slot) glds16(vsrc+(long)(t)*KVBLK*DM,(unsigned)__builtin_amdgcn_readfirstlane(vdst+(slot)))
  const int vb0=(int)(lds0+LDS_V)+((lane>>4)&1)*32+(lane&3)*8+(4*hi+((lane&15)>>2))*64;
  const char*Kbase=shm+LDS_K;
  const int NT=(q0+QB)/KVBLK;
  const float thr=c2h[q0]+2.f*bnd+SKIP_T;
  int tl=NT-4;
  for(int t=lane;t<NT-4;t+=64){ if(!(c2h[64*t+63]>thr)) tl=min(tl,t); }
  #pragma unroll
  for(int o_=32;o_>=1;o_>>=1) tl=min(tl,shflx_i(tl,o_,lane));
  tl=__builtin_amdgcn_readfirstlane(tl);
  const int n=NT-tl;
  DMA_K(NT-1,0);DMA_V(NT-1,0);
  for(int i=tid*4;i<64*n;i+=NW*64*4) *(f32x4a*)(CK+i)=*(const f32x4a*)(c2h+64*tl+i);
  bf16x8 qr[4];
  #pragma unroll
  for(int d0=0;d0<4;++d0)qr[d0]=*reinterpret_cast<const bf16x8*>(&Qw[(long)r32*DM+d0*16+hi*8]);
  const float cq=c2h[q0+wid*QBLK+r32];
  float mhat=-bnd,l_reg=0.f;f32x16 o[2];o[0]=f32x16{};o[1]=f32x16{};f32x16 negm;
  #pragma unroll
  for(int r=0;r<16;++r)negm[r]=cq-mhat;
  const int qrel=wid*QBLK+r32;
  int sl=0,sl_n=SLOTB;
  for(int it=0;it<n;++it){
    const int t=NT-1-it;
    if(it+1<n){ DMA_K(t-1,sl_n); DMA_V(t-1,sl_n); WAIT_BAR(2); } else { WAIT_BAR(0); }
    if(!(it<4 && 64*(3-it)>32*wid+31)){
    f32x16 p0,p1;
    qkt(p0,p1,Kbase+sl,qr,negm,r32,hi);
    { const float*ckt=CK+(t-tl)*64+4*hi;
      #pragma unroll
      for(int g=0;g<4;++g){ const f32x4a ca=*(const f32x4a*)(ckt+8*g), cb=*(const f32x4a*)(ckt+32+8*g);
        #pragma unroll
        for(int i=0;i<4;++i){ p0[4*g+i]-=ca[i]; p1[4*g+i]-=cb[i]; } } }
    if(it<4)cmask(p0,p1,3-it,qrel,hi);
    float rm;
    { float a=__builtin_fmaxf(p0[0],p1[0]);
      #pragma unroll
      for(int r=1;r<16;++r)a=__builtin_fmaxf(a,__builtin_fmaxf(p0[r],p1[r]));
      auto rr=__builtin_amdgcn_permlane32_swap(__float_as_uint(a),__float_as_uint(a),false,false);
      rm=__builtin_fmaxf(__uint_as_float(rr[0]),__uint_as_float(rr[1])); }
    const float mnew=__builtin_fmaxf(mhat,rm), dl=mnew-mhat;
    if(__any(dl>0.f)){
      const float f=__builtin_amdgcn_exp2f(-dl); l_reg*=f; if(hi==0)wsf[r32]=f;
      asm volatile("s_waitcnt lgkmcnt(0)":::"memory");
      #pragma unroll
      for(int d_=0;d_<2;++d_)
        #pragma unroll
        for(int r=0;r<16;++r)o[d_][r]*=wsf[crow(r,hi)];
      mhat=mnew;
      #pragma unroll
      for(int r=0;r<16;++r){negm[r]=cq-mhat;p0[r]-=dl;p1[r]-=dl;}
    }
    float sacc=0.f;
    #pragma unroll
    for(int r=0;r<16;++r){p0[r]=__builtin_amdgcn_exp2f(p0[r]);p1[r]=__builtin_amdgcn_exp2f(p1[r]);sacc+=p0[r]+p1[r];}
    l_reg+=sacc;
    { u32x4 pw0,pw1,pw2,pw3;
      #define PKW(P,B) cvtpk_s(P[B],P[B+1])
      pw0=(u32x4){PKW(p0,0),PKW(p0,2),PKW(p0,4),PKW(p0,6)};pw1=(u32x4){PKW(p0,8),PKW(p0,10),PKW(p0,12),PKW(p0,14)};pw2=(u32x4){PKW(p1,0),PKW(p1,2),PKW(p1,4),PKW(p1,6)};pw3=(u32x4){PKW(p1,8),PKW(p1,10),PKW(p1,12),PKW(p1,14)};
      #undef PKW
      SBAR(); pv(o,vb0+sl,__builtin_bit_cast(bf16x8,pw0),__builtin_bit_cast(bf16x8,pw1),__builtin_bit_cast(bf16x8,pw2),__builtin_bit_cast(bf16x8,pw3)); }
    }
    sl=sl_n; sl_n=(sl_n==(NSLOT-1)*SLOTB)?0:sl_n+SLOTB;
  }
  asm volatile("s_waitcnt lgkmcnt(0)\n\ts_barrier":::"memory");
  {auto rr=__builtin_amdgcn_permlane32_swap(__float_as_uint(l_reg),__float_as_uint(l_reg),false,false);l_reg=__uint_as_float(rr[0])+__uint_as_float(rr[1]);}
  if(hi==0)wsf[32+r32]=l_reg;asm volatile("s_waitcnt lgkmcnt(0)":::"memory");
  float rli[16];
  #pragma unroll
  for(int r=0;r<16;++r)rli[r]=__builtin_amdgcn_rcpf(wsf[32+crow(r,hi)]);
  bf16*Ow=O+(rowbase+q0+wid*QBLK)*DM+h*D;
  { bf16*stg=(bf16*)(shm+LDS_OST)+wid*2048;
    #pragma unroll
    for(int r=0;r<16;++r){const int orow=crow(r,hi);
      #pragma unroll
      for(int d0=0;d0<2;++d0)stg[orow*64+d0*32+r32]=__float2bfloat16(o[d0][r]*rli[r]);}
    asm volatile("s_waitcnt lgkmcnt(0)":::"memory");
    #pragma unroll
    for(int i=0;i<4;++i){const int row=i*8+(lane>>3),ch=lane&7; const u32x4 v=*(const u32x4*)(stg+row*64+ch*8); ATTN_STORE16(Ow+(long)row*DM+ch*8,v);} }
  asm volatile("s_waitcnt lgkmcnt(0)\n\ts_barrier":::"memory");
  #undef DMA_K
  #undef DMA_V
}
constexpr int ATTN_LDS_BYTES=LDS_BYTES;
#undef SBAR
#undef WAIT_BAR
}
constexpr int NWAVES = 8;
constexpr int BATCH = 2, SEQ = 16384, D = 1024, H = 16, HD = 64, FF = 4096, PLE = 256, DEPTH = 4;
constexpr int M = BATCH * SEQ;
constexpr int NIN_ATT = 3 * D + H;
constexpr float RMS_EPS = 1e-6f;
constexpr float LOG2E = 1.4426950408889634f;
constexpr size_t MiB = 1u << 20;
constexpr size_t WS_CTL = 0, CTL_ZERO_BYTES = 1 * MiB;
constexpr size_t WS_C2 = 1 * MiB, WS_FLOG = 3 * MiB;
constexpr size_t WS_X1 = 5 * MiB, WS_X2 = 6 * MiB, WS_RS = 7 * MiB;
constexpr size_t WS_WIN = 8 * MiB, WS_WOUT = 15 * MiB, WS_WUP = 17 * MiB, WS_WDN = 25 * MiB, WS_WG = 33 * MiB, WS_WP = 35 * MiB, WS_WALT = 3 * MiB;
constexpr size_t WS_PB = 40 * MiB, WS_PB2 = 56 * MiB  , WS_QO = 120 * MiB, WS_K = 184 * MiB, WS_V = 248 * MiB, WS_H = 120 * MiB, WS_Y = 376 * MiB  , WS_XB = 440 * MiB  , WS_END = 504 * MiB;
constexpr int CW_TMO = 0, CW_SEAM = 16384, SEAM_BANK = 128 * 64;
constexpr int CW_ATTQ = 2048;
constexpr int CW_QKMAX = 1024;
constexpr int RING_OFF = 0, RING_BYTES = 131072, LDS_BYTES = 147456;
static_assert(attn_body::ATTN_LDS_BYTES <= RING_BYTES, "attention LDS");

#define GAS __attribute__((address_space(1)))
#define LAS __attribute__((address_space(3)))
typedef unsigned short bf16;
typedef unsigned v4u __attribute__((ext_vector_type(4)));
typedef float f32x4 __attribute__((ext_vector_type(4)));
#define LDS_WAIT() asm volatile("s_waitcnt lgkmcnt(0)" ::: "memory")
__device__ __forceinline__ unsigned f2bf(float f) { unsigned u = __builtin_bit_cast(unsigned, f); return (u + 0x7fffu + ((u >> 16) & 1u)) >> 16; }
__device__ __forceinline__ unsigned pk2(float lo, float hi) { return f2bf(lo) | (f2bf(hi) << 16); }
__device__ __forceinline__ float wave_sum(float v) {
#pragma unroll
    for (int o = 1; o < 64; o <<= 1) v += __shfl_xor(v, o);
    return v;
}
__device__ __forceinline__ void transpose_item(const float* W, int K, int N, int ldn, bf16* WT, int row_off, LAS float* scr, int item, int lane, const float* g = nullptr, int cumode = 0) {
    const int nblk = N / 32, kb = item / nblk, nb = item % nblk, k0 = 64 * kb, n0 = 32 * nb;
    int srcc = n0 + 4 * (lane & 7);
    if (cumode && srcc >= 1024) { const int cu = srcc - 1024, col = cu & 255; srcc = (((col >> 2) & 1) ? 2048 : 1024) + (cu >> 8) * 128 + (col >> 6) * 32 + ((col >> 3) & 3) * 8 + ((col >> 5) & 1) * 4; }
    { f32x4 t[8];
#pragma unroll
      for (int i = 0; i < 8; ++i) t[i] = *(const GAS f32x4*)(W + (size_t)(k0 + 8 * i + (lane >> 3)) * ldn + srcc);
      if (g) {
#pragma unroll
        for (int i = 0; i < 8; ++i) t[i] = t[i] * g[k0 + 8 * i + (lane >> 3)]; }
#pragma unroll
      for (int i = 0; i < 8; ++i) { LAS float* d = scr + (8 * i + (lane >> 3)) * 33 + 4 * (lane & 7); d[0] = t[i].x; d[1] = t[i].y; d[2] = t[i].z; d[3] = t[i].w; } }
    LDS_WAIT(); asm volatile("" ::: "memory");
    const int c = lane & 7;
#pragma unroll
    for (int j = 0; j < 4; ++j) { const int n = (lane >> 3) + 8 * j; const LAS float* s = scr + (8 * c) * 33 + n;
        v4u o; o.x = pk2(s[0 * 33], s[1 * 33]); o.y = pk2(s[2 * 33], s[3 * 33]); o.z = pk2(s[4 * 33], s[5 * 33]); o.w = pk2(s[6 * 33], s[7 * 33]);
        *(GAS v4u*)(WT + (size_t)(row_off + n0 + n) * K + k0 + 8 * c) = o; }
    LDS_WAIT(); asm volatile("" ::: "memory");
}
struct Args { const float* in[13]; float* out; unsigned char* ws; };
typedef volatile LAS unsigned long long* PTab;
__device__ __forceinline__ unsigned long long ptab_raw(PTab PT, int i) { const unsigned a_ = (unsigned)opq_s((int)(unsigned)(size_t)PT + 8 * i);
    const unsigned long long v = *(volatile LAS unsigned long long*)a_; return ((unsigned long long)(unsigned)__builtin_amdgcn_readfirstlane((int)(unsigned)(v >> 32)) << 32) | (unsigned)__builtin_amdgcn_readfirstlane((int)(unsigned)v); }
__device__ __forceinline__ const float* ptab_in(PTab PT, int i) { return (const float*)(const GAS float*)ptab_raw(PT, i); }
__device__ __forceinline__ unsigned char* ptab_ws(PTab PT) { return (unsigned char*)(GAS unsigned char*)ptab_raw(PT, 14); }
__device__ __forceinline__ float* ptab_out(PTab PT) { return (float*)(GAS float*)ptab_raw(PT, 13); }
__device__ __forceinline__ void convert_layer(PTab PT, int li, LAS unsigned char* lds, int gw, int NGW, int wave, int lane_, int part = 0) {
    const int lane = opq_v(lane_);
    LAS float* scr = (LAS float*)(lds + RING_OFF + wave * 16384);
    unsigned char* ws = ptab_ws(PT); const int j = li >> 1; const bool att = (li & 1) == 0;
    const float* Win = att ? ptab_in(PT, 3) + (size_t)j * D * NIN_ATT : ptab_in(PT, 6) + (size_t)j * D * 3 * D; const int ldin = att ? NIN_ATT : 3 * D;
    const float* Wout = att ? ptab_in(PT, 5) + (size_t)j * D * D : ptab_in(PT, 8) + (size_t)j * D * D;
    const float* Wup = ptab_in(PT, 9) + (size_t)li * D * FF; const float* Wdn = ptab_in(PT, 10) + (size_t)li * FF * D;
    const float* Wp = ptab_in(PT, 11) + (size_t)li * PLE * D; const float* Wg = ptab_in(PT, 12) + (size_t)li * D * D;
    const float* gn = ptab_in(PT, 2) + (size_t)li * 6 * D;
    constexpr int I_IN = (D / 64) * (3 * D / 32), I_O = (D / 64) * (D / 32), I_UP = (D / 64) * (FF / 32), I_DN = (FF / 64) * (D / 32), I_G = I_O, I_P = (PLE / 64) * (D / 32), I_F = D / 64;
    const int nF = att ? I_F : 0, NITEMS = I_IN + nF + I_O + I_UP + I_DN + I_G + I_P;
    const int it_lo = part == 2 ? I_IN + nF : 0, it_hi = part == 1 ? I_IN + nF : NITEMS;
    for (int it = it_lo + gw; it < it_hi; it += NGW) {
        int r = it;
        if (r < I_IN) { transpose_item(Win, D, 3 * D, ldin, (bf16*)(ws + WS_WIN), 0, scr, r, lane, gn, att ? 0 : 1); continue; } r -= I_IN;
        if (r < nF) {
            bf16* WT = (bf16*)(ws + WS_WIN);
#pragma unroll 4
            for (int e = lane; e < 64 * 16; e += 64) { const int kk = e >> 4, jj = e & 15; WT[(size_t)(3 * D + jj) * D + 64 * r + kk] = (bf16)f2bf(Win[(size_t)(64 * r + kk) * NIN_ATT + 3 * D + jj] * gn[64 * r + kk]); }
            continue; } r -= nF;
        if (r < I_O) { transpose_item(Wout, D, D, D, (bf16*)(ws + WS_WOUT), 0, scr, r, lane); continue; } r -= I_O;
        if (r < I_UP) { transpose_item(Wup, D, FF, FF, (bf16*)(ws + WS_WUP), 0, scr, r, lane, gn + 2 * D); continue; } r -= I_UP;
        if (r < I_DN) { transpose_item(Wdn, FF, D, D, (bf16*)(ws + WS_WDN), 0, scr, r, lane); continue; } r -= I_DN;
        if (r < I_G) { transpose_item(Wg, D, D, D, (bf16*)(ws + WS_WG + (li & 1) * WS_WALT), 0, scr, r, lane, gn + 4 * D); continue; } r -= I_G;
        transpose_item(Wp, PLE, D, D, (bf16*)(ws + WS_WP + (li & 1) * WS_WALT), 0, scr, r, lane);
    }
}
__device__ __forceinline__ void p0_rows(const float* xsrc, bf16* XBp, float* rs, int gw, int NGW, int lane_) {
    const int lane = opq_v(lane_);
    for (int m = 2 * gw; m < M; m += 2 * NGW) {
        f32x4 v[2][4]; float sq[2];
#pragma unroll
        for (int r = 0; r < 2; ++r) { const GAS f32x4* xr = (const GAS f32x4*)(xsrc + (size_t)(m + r) * D) + lane;
#pragma unroll
            for (int j = 0; j < 4; ++j) v[r][j] = xr[64 * j]; }
#pragma unroll
        for (int r = 0; r < 2; ++r) { sq[r] = 0.f;
#pragma unroll
            for (int j = 0; j < 4; ++j) sq[r] += (v[r][j].x * v[r][j].x + v[r][j].y * v[r][j].y) + (v[r][j].z * v[r][j].z + v[r][j].w * v[r][j].w); }
#pragma unroll
        for (int o = 1; o < 64; o <<= 1) { sq[0] += shflx_f(sq[0], o, lane); sq[1] += shflx_f(sq[1], o, lane); }
#pragma unroll
        for (int r = 0; r < 2; ++r) { if (lane == 0) rs[m + r] = 1.f / sqrtf(sq[r] * (1.f / D) + RMS_EPS);
            GAS unsigned long long* o8 = (GAS unsigned long long*)(XBp + (size_t)(m + r) * D) + lane;
#pragma unroll
            for (int j = 0; j < 4; ++j) o8[64 * j] = (unsigned long long)pk2(v[r][j].x, v[r][j].y) | ((unsigned long long)pk2(v[r][j].z, v[r][j].w) << 32); }
    }
}
__device__ __forceinline__ void p_phase(const float* psrc, bf16* pdst, int gw, int NGW, int lane_) {
    const int lane = opq_v(lane_);
    for (int m = 8 * gw; m < M; m += 8 * NGW) {
        f32x4 q[8];
#pragma unroll
        for (int r = 0; r < 8; ++r) q[r] = ((const GAS f32x4*)(psrc + (size_t)(m + r) * PLE))[lane];
#pragma unroll
        for (int r = 0; r < 8; ++r) ((GAS unsigned long long*)(pdst + (size_t)(m + r) * PLE))[lane] = (unsigned long long)pk2(q[r].x, q[r].y) | ((unsigned long long)pk2(q[r].z, q[r].w) << 32);
    }
}
__device__ __forceinline__ void bf8_to_f32(const v4u w, float (&f)[8]) {
    f[0] = __uint_as_float(w.x << 16); f[1] = __uint_as_float(w.x & 0xffff0000u); f[2] = __uint_as_float(w.y << 16); f[3] = __uint_as_float(w.y & 0xffff0000u);
    f[4] = __uint_as_float(w.z << 16); f[5] = __uint_as_float(w.z & 0xffff0000u); f[6] = __uint_as_float(w.w << 16); f[7] = __uint_as_float(w.w & 0xffff0000u);
}
__device__ __forceinline__ void conv_phase(const bf16* Bq, const bf16* Z, bf16* Yo, const float* cw, int gt_, int NGT) {
    const int gt = opq_v(gt_);
    constexpr int NITEMS = (M / 32) * (D / 8);
    for (int it = gt; it < NITEMS; it += NGT) {
        const int cgp = it & 127, rc = it >> 7, col = cgp * 8, t0 = rc * 32;
        float w0[8], w1[8], w2[8];
#pragma unroll
        for (int i = 0; i < 8; ++i) { w0[i] = cw[col + i]; w1[i] = cw[D + col + i]; w2[i] = cw[2 * D + col + i]; }
        float z1[8], z2[8];
        if ((t0 & (SEQ - 1)) == 0) {
#pragma unroll
            for (int i = 0; i < 8; ++i) { z1[i] = 0.f; z2[i] = 0.f; }
        } else {
            bf8_to_f32(*(const GAS v4u*)(Z + (size_t)(t0 - 1) * D + col), z1); bf8_to_f32(*(const GAS v4u*)(Z + (size_t)(t0 - 2) * D + col), z2);
        }
#pragma unroll 4
        for (int r = 0; r < 32; ++r) {
            const size_t off = (size_t)(t0 + r) * D + col;
            float z[8], bg[8], y[8];
            bf8_to_f32(*(const GAS v4u*)(Z + off), z); bf8_to_f32(*(const GAS v4u*)(Bq + off), bg);
#pragma unroll
            for (int i = 0; i < 8; ++i) { y[i] = bg[i] * (w0[i] * z2[i] + w1[i] * z1[i] + w2[i] * z[i]); z2[i] = z1[i]; z1[i] = z[i]; }
            v4u o; o.x = pk2(y[0], y[1]); o.y = pk2(y[2], y[3]); o.z = pk2(y[4], y[5]); o.w = pk2(y[6], y[7]);
            *(GAS v4u*)(Yo + off) = o;
        }
    }
}
__device__ __forceinline__ void logit_phase(const bf16* XNp, const bf16* Wf, const float* rs, float* flog, int gw, int NGW, int lane_) {
    typedef short bf16x8v __attribute__((ext_vector_type(8)));
    const int lane = opq_v(lane_), fr = lane & 15, fq = lane >> 4;
    for (int blk = gw; blk < M / 16; blk += NGW) {
        const bf16* ap = XNp + (size_t)(blk * 16 + fr) * D + 8 * fq; const bf16* bp = Wf + (size_t)fr * D + 8 * fq;
        f32x4 acc = {0.f, 0.f, 0.f, 0.f};
#pragma unroll 8
        for (int kk = 0; kk < D / 32; ++kk) { const bf16x8v w = *(const GAS bf16x8v*)(bp + 32 * kk), a = *(const GAS bf16x8v*)(ap + 32 * kk); acc = __builtin_amdgcn_mfma_f32_16x16x32_bf16(w, a, acc, 0, 0, 0); }
        acc = acc * rs[blk * 16 + fr];
        { const int row = blk * 16 + fr; float* fo = flog + ((size_t)((row >> 14) * 16 + 4 * fq) << 14) + (row & (SEQ - 1));
#pragma unroll
          for (int i = 0; i < 4; ++i) fo[(size_t)i << 14] = acc[i]; }
    }
}
__device__ __forceinline__ void gate_phase(const float* flog, const float* bfv, float* c2, unsigned* qkmax, const bf16* Q, const bf16* Kb, LAS unsigned char* lds, int G, int tid_, int wave, int lane_) {
    const int tid = opq_v(tid_), lane = opq_v(lane_);
    if (blockIdx.x < 32) {
        const int bh = blockIdx.x, b = bh >> 4, h = bh & 15; const float bias = bfv[h];
        const GAS f32x4* fp = (const GAS f32x4*)(flog + (size_t)bh * SEQ + 32 * tid);
        f32x4 zin[8];
#pragma unroll
        for (int k = 0; k < 8; ++k) zin[k] = fp[k];
        float v[32]; float run = 0.f;
#pragma unroll
        for (int k = 0; k < 32; ++k) { const float z = zin[k >> 2][k & 3] + bias; const float ls = fminf(z, 0.f) - __logf(1.f + __expf(-fabsf(z)));   run += ls; v[k] = run; }
        float incl = run;
#pragma unroll
        for (int o = 1; o < 64; o <<= 1) { const float y = __int_as_float(__builtin_amdgcn_ds_bpermute(((lane - o) & 63) << 2, __float_as_int(incl))); if (lane >= o) incl += y; }
        LAS float* wt = (LAS float*)lds;
        if (lane == 63) wt[wave] = incl;
        __syncthreads();
        float base = 0.f;
        for (int w = 0; w < wave; ++w) base += wt[w];
        const float excl = base + incl - run;
        GAS f32x4* dst = (GAS f32x4*)(c2 + (size_t)bh * SEQ + 32 * tid);
#pragma unroll
        for (int k = 0; k < 8; ++k) dst[k] = (f32x4){(excl + v[4 * k]) * LOG2E, (excl + v[4 * k + 1]) * LOG2E, (excl + v[4 * k + 2]) * LOG2E, (excl + v[4 * k + 3]) * LOG2E};
        __syncthreads();
    } else if (qkmax) {
        LAS unsigned* lm = (LAS unsigned*)lds;
        if (tid < 64) lm[tid] = 0u;
        __syncthreads();
        const int gw = (blockIdx.x - 32) * NWAVES + wave, NGW = (G - 32) * NWAVES;
#pragma unroll
        for (int b = 0; b < 2; ++b) {
            float mq[2] = {0.f, 0.f}, mk[2] = {0.f, 0.f};
            for (int r = 2 * gw; r < SEQ; r += 2 * NGW) {
                const size_t off0 = ((size_t)b * SEQ + r) * D + lane * 8;
                v4u qv[4], kv[4];
#pragma unroll
                for (int j = 0; j < 4; ++j) { qv[j] = *(const GAS v4u*)(Q + off0 + 512 * j); kv[j] = *(const GAS v4u*)(Kb + off0 + 512 * j); }
#pragma unroll
                for (int jj = 0; jj < 4; ++jj) { const int j = jj & 1;
                    float q[8], k[8]; bf8_to_f32(qv[jj], q); bf8_to_f32(kv[jj], k);
                    float sq = 0.f, sk = 0.f;
#pragma unroll
                    for (int i = 0; i < 8; ++i) { sq += q[i] * q[i]; sk += k[i] * k[i]; }
                    sq += shflx_f(sq, 1, lane); sk += shflx_f(sk, 1, lane); sq += shflx_f(sq, 2, lane); sk += shflx_f(sk, 2, lane); sq += shflx_f(sq, 4, lane); sk += shflx_f(sk, 4, lane);
                    mq[j] = fmaxf(mq[j], sq); mk[j] = fmaxf(mk[j], sk);
                }
            }
            if ((lane & 7) == 0) {
#pragma unroll
                for (int j = 0; j < 2; ++j) { const int hh = 8 * j + (lane >> 3); atomicMax((unsigned*)&lm[(b * 16 + hh) * 2], __float_as_uint(mq[j])); atomicMax((unsigned*)&lm[(b * 16 + hh) * 2 + 1], __float_as_uint(mk[j])); }
            }
        }
        __syncthreads();
        if (tid < 64) __hip_atomic_fetch_max(qkmax + tid, lm[tid], __ATOMIC_RELAXED, __HIP_MEMORY_SCOPE_AGENT);
        __syncthreads();
    }
}
#define RLX_AGENT __ATOMIC_RELAXED, __HIP_MEMORY_SCOPE_AGENT
constexpr int CW_BAR = 4096;
#define XB_TMO      128
#define XB_XCNT(j)  (256  + 64 * (j))
#define XB_XSUB(j)  (1280 + 64 * (j))
#define XB_XGEN(j)  (2304 + 64 * (j))
#define XB_TOP      3328
#define XB_TOPGEN   3392
#define XCD_BAR_WORDS 3456
#define XB_SPIN_CAP (1u << 18)

__device__ __forceinline__ unsigned xb_ld(unsigned* p)              { return __hip_atomic_load(p, __ATOMIC_RELAXED, __HIP_MEMORY_SCOPE_AGENT); }
__device__ __forceinline__ unsigned xb_add(unsigned* p, unsigned v) { return __hip_atomic_fetch_add(p, v, __ATOMIC_RELAXED, __HIP_MEMORY_SCOPE_AGENT); }
__device__ __forceinline__ unsigned xb_xcc_id() { return (unsigned)__builtin_amdgcn_s_getreg((3 << 11) | 20) & 0xFu; }
#define XB_SPIN(cond, bar) do { unsigned _sp = 0; while (cond) { __builtin_amdgcn_s_sleep(1); \
    if ((++_sp & 255u) == 0u) { if (xb_ld(&(bar)[XB_TMO])) break; if (_sp > XB_SPIN_CAP) { atomicAdd(&(bar)[XB_TMO], 1u); break; } } } } while (0)

struct XcdBarrier {
    unsigned* bar; unsigned x;
    volatile LAS unsigned* st;
};

__device__ __forceinline__ XcdBarrier xcd_barrier_post(unsigned* bar, volatile LAS unsigned* st) {
    XcdBarrier b; b.bar = bar; b.x = xb_xcc_id(); b.st = st;
    if (threadIdx.x == 0) (void)xb_add(&bar[XB_XCNT(b.x)], 1u);
    return b;
}
__device__ __forceinline__ void xcd_barrier_complete(unsigned* bar, unsigned x, unsigned& nloc, unsigned& nx) {
    const unsigned G = gridDim.x * gridDim.y * gridDim.z;
    unsigned sum, cnt, mine, sp = 0u;
    for (;;) {
        sum = 0u; cnt = 0u; mine = 0u;
#pragma unroll
        for (unsigned j = 0; j < 16; ++j) { const unsigned c = xb_ld(&bar[XB_XCNT(j)]); sum += c; cnt += (c > 0u) ? 1u : 0u; mine = (j == x) ? c : mine; }
        if (sum == G) break;
        __builtin_amdgcn_s_sleep(1);
        if ((++sp & 255u) == 0u) { if (xb_ld(&bar[XB_TMO])) break; if (sp > XB_SPIN_CAP) { atomicAdd(&bar[XB_TMO], 1u); break; } }
    }
    nloc = mine > 0u ? mine : 1u; nx = cnt > 0u ? cnt : 1u;
}

__device__ __forceinline__ void xcd_barrier(const XcdBarrier& b) {
    asm volatile("s_waitcnt vmcnt(0)" ::: "memory");
    __syncthreads();
    if (threadIdx.x == 0) {
        unsigned* bar = b.bar;
        __builtin_amdgcn_s_waitcnt(0);
        unsigned nloc = b.st[0], nx = b.st[1];
        if (nloc == 0u) { xcd_barrier_complete(bar, b.x, nloc, nx); b.st[0] = nloc; b.st[1] = nx; }
        const unsigned old = xb_add(&bar[XB_XSUB(b.x)], 1u);
        const unsigned gen = old / nloc;
        if (old + 1u == (gen + 1u) * nloc) {
            __builtin_amdgcn_fence(__ATOMIC_RELEASE, "agent");
            asm volatile("s_waitcnt vmcnt(0)" ::: "memory");
            const unsigned og = xb_add(&bar[XB_TOP], 1u);
            const unsigned tg = og / nx;
            if (og + 1u == (tg + 1u) * nx) xb_add(&bar[XB_TOPGEN], 1u);
            else XB_SPIN(xb_ld(&bar[XB_TOPGEN]) == tg, bar);
            __builtin_amdgcn_fence(__ATOMIC_ACQUIRE, "agent");
            xb_add(&bar[XB_XGEN(b.x)], 1u);
            asm volatile("s_waitcnt vmcnt(0)" ::: "memory");
        } else {
            __builtin_amdgcn_fence(__ATOMIC_ACQUIRE, "agent");
            asm volatile("s_waitcnt vmcnt(0)" ::: "memory");
            XB_SPIN(xb_ld(&bar[XB_XGEN(b.x)]) == gen, bar);
            asm volatile("" ::: "memory");
            asm volatile("s_waitcnt vmcnt(0)" ::: "memory");
        }
    }
    __syncthreads();
}

__global__ void __launch_bounds__(NWAVES * 64, 2) trunk_fwd(Args args) {
    extern __shared__ __attribute__((aligned(16))) unsigned char lds[];
    cg::grid_group grid = cg::this_grid();
    LAS unsigned char* L = (LAS unsigned char*)lds;
#define tid (opq_v((int)threadIdx.x))
#define lane (opq_v((int)threadIdx.x) & 63)
#define wave (__builtin_amdgcn_readfirstlane(opq_v((int)threadIdx.x) >> 6))
#define G (opq_s((int)gridDim.x))
#define bx (opq_s((int)blockIdx.x))
#define vcu (((int)gridDim.x % 8 == 0) ? (bx % 8) * ((int)gridDim.x / 8) + bx / 8 : bx)
#define gw (vcu * NWAVES + wave)
#define NGW (G * NWAVES)
    PTab PT = (PTab)(L + RING_BYTES);
    if (threadIdx.x == 0) {
#pragma unroll
        for (int i = 0; i < 13; ++i) PT[i] = (unsigned long long)args.in[i];
        PT[13] = (unsigned long long)args.out; PT[14] = (unsigned long long)args.ws;
    }
    __syncthreads();
    volatile LAS unsigned* xb_st = (volatile LAS unsigned*)(L + RING_BYTES + 256);
    if (threadIdx.x == 0) { xb_st[0] = 0u; xb_st[1] = 0u; }
    __syncthreads();
    (void)xcd_barrier_post((unsigned*)(ptab_ws(PT) + WS_CTL) + CW_BAR, xb_st);
#define GRID_SYNC() do { XcdBarrier b_; b_.bar = (unsigned*)(ptab_ws(PT) + WS_CTL) + CW_BAR; b_.x = xb_xcc_id(); b_.st = (volatile LAS unsigned*)(L + RING_BYTES + 256); xcd_barrier(b_); } while (0)
#define WSB(T, off) ((T*)(ptab_ws(PT) + (off)))

    convert_layer(PT, 0, L, gw, NGW, wave, lane, 1);
    p0_rows(ptab_in(PT, 0), WSB(bf16, WS_XB), WSB(float, WS_RS), gw, NGW, lane);
    GRID_SYNC();
    if (gridDim.y == 0xFFFFu) grid.sync();

#pragma unroll 1
    for (int li = 0; li < DEPTH; ++li) {
        const int j = li >> 1;
        if ((li & 1) == 0) {
            { pg8::Gemm gm{WSB(bf16, WS_XB), WSB(bf16, WS_WIN), M, 3 * D, D}; pg8::StaticOrder S; S.init(M, 3 * D, G, bx);
              pg8::EpiBf16<0> E{WSB(bf16, WS_QO), D, D, (size_t)(WS_K - WS_QO) / 2, attn_body::C2, nullptr, WSB(float, WS_RS), WSB(unsigned, WS_CTL) + CW_QKMAX + j * 128};
              pg8::gemm_phase<pg8::EpiBf16<0>, pg8::StaticOrder, true, true>(L + RING_OFF, gm, S, E); }
            logit_phase(WSB(bf16, WS_XB), WSB(bf16, WS_WIN) + (size_t)3 * D * D, WSB(float, WS_RS), WSB(float, WS_FLOG), gw, NGW, lane);
            if (li == 0) convert_layer(PT, 0, L, gw, NGW, wave, lane, 2);
            GRID_SYNC();
            if (bx >= 32) {
                p_phase(ptab_in(PT, 1) + (size_t)li * M * PLE, WSB(bf16, WS_PB), (bx - 32) * NWAVES + wave, (G - 32) * NWAVES, lane);
                p_phase(ptab_in(PT, 1) + (size_t)(li + 1) * M * PLE, WSB(bf16, WS_PB2), (bx - 32) * NWAVES + wave, (G - 32) * NWAVES, lane); }
            gate_phase(WSB(float, WS_FLOG), ptab_in(PT, 4) + j * H, WSB(float, WS_C2), nullptr, WSB(bf16, WS_QO), WSB(bf16, WS_K), L, G, tid, wave, lane);
            GRID_SYNC();
            volatile LAS int* wq_ = (volatile LAS int*)(L + RING_BYTES + 512);
            for (;;) {
                if (wave == 0 && lane == 0) *wq_ = (int)__hip_atomic_fetch_add(WSB(unsigned, WS_CTL) + CW_ATTQ + j * 64, 1u, __ATOMIC_RELAXED, __HIP_MEMORY_SCOPE_AGENT);
                __syncthreads();
                const int u = __builtin_amdgcn_readfirstlane(*wq_);
                __syncthreads();
                if (u >= BATCH * H * (SEQ / 256)) break;
                const int bh = u >> 6, qb = u & 63;
                unsigned* qkmax = WSB(unsigned, WS_CTL) + CW_QKMAX + j * 128 + bh * 4;
                const float qm = __uint_as_float(__hip_atomic_load(qkmax + 0, __ATOMIC_RELAXED, __HIP_MEMORY_SCOPE_AGENT)) + __uint_as_float(__hip_atomic_load(qkmax + 1, __ATOMIC_RELAXED, __HIP_MEMORY_SCOPE_AGENT));
                const float km = __uint_as_float(__hip_atomic_load(qkmax + 2, __ATOMIC_RELAXED, __HIP_MEMORY_SCOPE_AGENT)) + __uint_as_float(__hip_atomic_load(qkmax + 3, __ATOMIC_RELAXED, __HIP_MEMORY_SCOPE_AGENT));
                const float bnd = sqrtf(qm * km) * 1.02f + 1.0f;
                attn_body::fox_unit(bh >> 4, bh & 15, qb, (const attn_body::bf16*)WSB(bf16, WS_QO), (const attn_body::bf16*)WSB(bf16, WS_K), (const attn_body::bf16*)WSB(bf16, WS_V), (attn_body::bf16*)WSB(bf16, WS_QO), WSB(float, WS_C2) + (size_t)bh * SEQ, bnd, (char*)lds + RING_OFF);
            }
            GRID_SYNC();
        } else {
            { pg8::Gemm gm{WSB(bf16, WS_XB), WSB(bf16, WS_WIN), M, 3 * D, D}; pg8::StaticOrder S; S.init(M, 3 * D, G, bx);
              pg8::EpiBf16<4> E{WSB(bf16, WS_QO), D, D, (size_t)(WS_K - WS_QO) / 2, 1.f, nullptr, WSB(float, WS_RS), nullptr};
              pg8::gemm_phase<pg8::EpiBf16<4>, pg8::StaticOrder, true, true>(L + RING_OFF, gm, S, E); }
            GRID_SYNC();
            conv_phase(WSB(bf16, WS_QO), WSB(bf16, WS_K), WSB(bf16, WS_QO), ptab_in(PT, 7) + (size_t)j * 3 * D, vcu * NWAVES * 64 + tid, G * NWAVES * 64);
            GRID_SYNC();
        }
#define FUSED_GEMM(Aoff, Woff, KK, MUL, GA, IDX) do { \
            pg8::Gemm gm{WSB(bf16, Aoff), WSB(bf16, Woff), M, D, KK}; pg8::StaticOrder S; S.init(M, D, G, bx); \
            const unsigned want_ = 32u * (unsigned)(li * 3 + (IDX) + 1); unsigned* ctl_ = WSB(unsigned, WS_CTL); \
            pg8::PanelRms s1_{WSB(unsigned, WS_X1), ctl_ + CW_SEAM, ctl_ + CW_TMO, want_, RMS_EPS, nullptr}, s2_{WSB(unsigned, WS_X2), ctl_ + CW_SEAM + SEAM_BANK, ctl_ + CW_TMO, want_, RMS_EPS, WSB(float, WS_RS)}; \
            const bool first_ = (li == 0 && (IDX) == 0), last_ = (li + 1 == DEPTH && (IDX) == 2); \
            pg8::EpiRms E{first_ ? (const void*)ptab_in(PT, 0) : (const void*)WSB(bf16, WS_XB), last_ ? (void*)ptab_out(PT) : (void*)WSB(bf16, WS_XB), MUL, GA, D, s1_, s2_, first_ ? 1 : 0, last_ ? 1 : 0, last_ ? 0 : 1}; \
            _Pragma("unroll 1") for (int rd_ = 0; rd_ < 2; ++rd_) { pg8::RoundOrder R{S, rd_}; pg8::gemm_phase<pg8::EpiRms, pg8::RoundOrder, false, true>(L + RING_OFF, gm, R, E); } } while (0)
        { const float* g = ptab_in(PT, 2) + (size_t)li * 6 * D;
          FUSED_GEMM(WS_QO, WS_WOUT, D, (const bf16*)nullptr, g + D, 0); }
        GRID_SYNC();
        { pg8::Gemm gm{WSB(bf16, WS_XB), WSB(bf16, WS_WUP), M, FF, D}; pg8::StaticOrder S; S.init(M, FF, G, bx);
          pg8::EpiBf16<2> E{WSB(bf16, WS_H), FF, 0, 0, 1.f, nullptr, WSB(float, WS_RS), nullptr};
          pg8::gemm_phase<pg8::EpiBf16<2>, pg8::StaticOrder, true, true>(L + RING_OFF, gm, S, E); }
        GRID_SYNC();
        { const float* g = ptab_in(PT, 2) + (size_t)li * 6 * D;
          FUSED_GEMM(WS_H, WS_WDN, FF, (const bf16*)nullptr, g + 3 * D, 1); }
        GRID_SYNC();
        { pg8::Gemm gm{WSB(bf16, WS_XB), WSB(bf16, WS_WG + (li & 1) * WS_WALT), M, D, D}; pg8::StaticOrder S; S.init(M, D, G, bx);
          pg8::EpiBf16<3> E{WSB(bf16, WS_Y), D, 0, 0, 1.f, nullptr, WSB(float, WS_RS), nullptr};
          pg8::gemm_phase<pg8::EpiBf16<3>, pg8::StaticOrder, true, true>(L + RING_OFF, gm, S, E); }
        { const float* g = ptab_in(PT, 2) + (size_t)li * 6 * D;
          FUSED_GEMM(((li & 1) ? WS_PB2 : WS_PB), WS_WP + (li & 1) * WS_WALT, PLE, (const bf16*)WSB(bf16, WS_Y), g + 5 * D, 2); }
        if (li + 1 < DEPTH) { convert_layer(PT, li + 1, L, gw, NGW, wave, lane); GRID_SYNC(); }
    }
#undef tid
#undef lane
#undef wave
#undef G
#undef bx
#undef vcu
#undef gw
#undef NGW
}

extern "C" void kernel_launch(void* const* d_in, const int* in_sizes, int n_in, void* d_out, int out_size, void* d_ws, size_t ws_size, hipStream_t stream) {
    static int grid = 0;
    if (grid == 0) {
        if (n_in != 13 || in_sizes[0] != M * D || out_size != M * D || ws_size < WS_END) { fprintf(stderr, "kernel_launch: unexpected shapes (n_in %d, in0 %d, out %d, ws %zu)\n", n_in, n_in > 0 ? in_sizes[0] : -1, out_size, ws_size); grid = -1; return; }
        int dev = 0, cus = 0, per_cu = 0;
        if (hipGetDevice(&dev) != hipSuccess || hipDeviceGetAttribute(&cus, hipDeviceAttributeMultiprocessorCount, dev) != hipSuccess) { grid = -1; return; }
        if (hipFuncSetAttribute((const void*)trunk_fwd, hipFuncAttributeMaxDynamicSharedMemorySize, LDS_BYTES) != hipSuccess) { fprintf(stderr, "kernel_launch: hipFuncSetAttribute failed\n"); grid = -1; return; }
        if (hipOccupancyMaxActiveBlocksPerMultiprocessor(&per_cu, (const void*)trunk_fwd, NWAVES * 64, LDS_BYTES) != hipSuccess || per_cu < 1) { fprintf(stderr, "kernel_launch: occupancy query says %d\n", per_cu); per_cu = 1; }
        (void)hipGetLastError();
        grid = cus * per_cu;
    }
    if (grid < 0) return;
    (void)hipMemsetAsync((char*)d_ws + WS_CTL, 0, CTL_ZERO_BYTES, stream);
    Args a{};
    for (int i = 0; i < 13; ++i) a.in[i] = (const float*)d_in[i];
    a.out = (float*)d_out; a.ws = (unsigned char*)d_ws;
    void* kargs[] = {&a};
    hipError_t e = hipLaunchCooperativeKernel((const void*)trunk_fwd, dim3(grid), dim3(NWAVES * 64), kargs, LDS_BYTES, stream);
    if (e != hipSuccess) fprintf(stderr, "cooperative launch failed: %s (grid %d)\n", hipGetErrorString(e), grid);
}
```
